# Optimizing an MI355X kernel written in HIP

```python
import jax, jax.numpy as jnp
from jax import lax
import numpy as np

D_MODEL = 2048
BATCH = 2
SEQ = 16384
DEPTH = 2
DEC_BATCH = 32
DEC_SEQ = 64
PAST_LEN = 2048

CHUNK = 64
W_A = D_MODEL
N_LRU_HEADS = 16
LRU_HEAD_DIM = W_A // N_LRU_HEADS
CONV_WIDTH = 4
LRU_C = 8.0
W_B = D_MODEL
POOL_WINDOWS = (2, 4, 8, 16)
N_POOL_GROUPS = 4
POOL_GROUP_DIM = W_B // N_POOL_GROUPS
POOL_PAD = POOL_WINDOWS[-1] - 1
D_IN = 2 * W_A + 2 * W_B + 2 * D_MODEL
EPS = 1e-6

kernel_name = "hybrid_rglru_pool_stream_step"


def rms_norm(x, g):
    xf = x.astype(jnp.float32)
    y = xf * lax.rsqrt(jnp.mean(xf * xf, axis=-1, keepdims=True) + EPS)
    return (y * g.astype(jnp.float32)).astype(x.dtype)


def causal_dwconv(xa, buf, w, b):
    T = xa.shape[1]
    xp = jnp.concatenate([buf.astype(xa.dtype), xa], axis=1)
    y = b
    for k in range(CONV_WIDTH):
        y = y + xp[:, k:k + T] * w[k]
    return y, xp[:, -(CONV_WIDTH - 1):]


def block_diag(x, w, b):
    bsz, T, _ = x.shape
    xh = x.reshape(bsz, T, N_LRU_HEADS, LRU_HEAD_DIM)
    return jnp.einsum('bthd,hde->bthe', xh, w).reshape(bsz, T, W_A) + b


def rg_lru(x, h0, wa, ba, wx, bx, lam):
    r = jax.nn.sigmoid(block_diag(x, wa, ba).astype(jnp.float32))
    i = jax.nn.sigmoid(block_diag(x, wx, bx).astype(jnp.float32))
    log_a = -LRU_C * r * jax.nn.softplus(-lam.astype(jnp.float32))
    a = jnp.exp(log_a)
    mult = jnp.sqrt(jnp.maximum(-jnp.expm1(2.0 * log_a), 0.0))
    u = mult * i * x.astype(jnp.float32)

    def combine(left, right):
        a1, b1 = left
        a2, b2 = right
        return a1 * a2, a2 * b1 + b2

    a_cum, b_cum = lax.associative_scan(combine, (a, u), axis=1)
    h = a_cum * h0.astype(jnp.float32)[:, None, :] + b_cum
    return h, h[:, -1]


def pool_mix(xb, buf, p0, pool_w, pool_scale):
    bsz, T, _ = xb.shape
    xp = jnp.concatenate([buf.astype(xb.dtype), xb], axis=1).astype(jnp.float32)
    S = jnp.concatenate([jnp.zeros((bsz, 1, W_B), jnp.float32), jnp.cumsum(xp, axis=1)], axis=1)
    pos = p0 + jnp.arange(T)
    outs = []
    for g, w in enumerate(POOL_WINDOWS):
        sl = slice(g * POOL_GROUP_DIM, (g + 1) * POOL_GROUP_DIM)
        win = S[:, POOL_PAD + 1:POOL_PAD + 1 + T, sl] - S[:, POOL_PAD + 1 - w:POOL_PAD + 1 - w + T, sl]
        cnt = jnp.minimum(w, pos + 1).astype(jnp.float32)[None, :, None]
        outs.append(win / cnt - xp[:, POOL_PAD:, sl])
    d = jnp.stack(outs, axis=2).astype(xb.dtype)
    y = jnp.einsum('btgc,gce->btge', d, pool_w).reshape(bsz, T, W_B)
    return y * pool_scale


def layer(x, c, conv_buf, h0, pool_buf, p0, norm_g, w_ada, b_ada, w_in, conv_w, conv_b,
          lru_wa, lru_ba, lru_wx, lru_bx, lru_lam, pool_w, pool_scale, w_proj_a, w_proj_b, w_out):
    mod = jax.nn.silu(c) @ w_ada + b_ada
    shift, scale, gate = jnp.split(mod, 3, axis=-1)
    h = rms_norm(x, norm_g) * (1.0 + scale[:, None]) + shift[:, None]
    z = h @ w_in
    xa, ga, xb, gb, ma, mb = jnp.split(
        z, [W_A, 2 * W_A, 2 * W_A + W_B, 2 * W_A + 2 * W_B, 2 * W_A + 2 * W_B + D_MODEL], axis=-1)
    xa_c, conv_new = causal_dwconv(xa, conv_buf, conv_w, conv_b)
    hs, h_last = rg_lru(xa_c, h0, lru_wa, lru_ba, lru_wx, lru_bx, lru_lam)
    ya = hs.astype(x.dtype) * jax.nn.silu(ga)
    yb = pool_mix(xb, pool_buf, p0, pool_w, pool_scale) * jax.nn.silu(gb)
    pool_new = jnp.concatenate([pool_buf.astype(xb.dtype), xb], axis=1)[:, -POOL_PAD:]
    m = jax.nn.sigmoid(ma) * (ya @ w_proj_a) + jax.nn.sigmoid(mb) * (yb @ w_proj_b)
    x = x + gate[:, None] * (m @ w_out)
    return x, conv_new, h_last.astype(x.dtype), pool_new


def setup_inputs(seed: int = 0) -> dict:
    key = jax.random.key(seed)
    ks = jax.random.split(key, 32)
    f32 = jnp.float32
    nrm = lambda k, s, sc: jax.random.normal(k, s, f32) * sc
    a0 = jax.random.uniform(ks[12], (DEPTH, W_A), f32, 0.9, 0.999)
    sig = a0 ** (1.0 / LRU_C)
    lru_lam = jnp.log(sig / (1.0 - sig))
    return {
        "x_prompt": nrm(ks[0], (BATCH, SEQ, D_MODEL), 1.0),
        "x_sample": nrm(ks[1], (DEC_BATCH, DEC_SEQ, D_MODEL), 1.0),
        "c_prompt": nrm(ks[2], (BATCH, D_MODEL), 1.0),
        "c_sample": nrm(ks[3], (DEC_BATCH, D_MODEL), 1.0),
        "state_conv": nrm(ks[4], (DEPTH, DEC_BATCH, CONV_WIDTH - 1, W_A), 1.0),
        "state_lru": nrm(ks[5], (DEPTH, DEC_BATCH, W_A), 0.5),
        "state_pool": nrm(ks[6], (DEPTH, DEC_BATCH, POOL_PAD, W_B), 1.0),
        "norm_g": 1.0 + nrm(ks[7], (DEPTH, D_MODEL), 0.05),
        "w_ada": nrm(ks[8], (DEPTH, D_MODEL, 3 * D_MODEL), D_MODEL ** -0.5),
        "b_ada": nrm(ks[9], (DEPTH, 3 * D_MODEL), 0.01),
        "w_in": nrm(ks[10], (DEPTH, D_MODEL, D_IN), D_MODEL ** -0.5),
        "conv_w": nrm(ks[11], (DEPTH, CONV_WIDTH, W_A), CONV_WIDTH ** -0.5),
        "conv_b": nrm(ks[13], (DEPTH, W_A), 0.01),
        "lru_wa": nrm(ks[14], (DEPTH, N_LRU_HEADS, LRU_HEAD_DIM, LRU_HEAD_DIM), LRU_HEAD_DIM ** -0.5),
        "lru_ba": nrm(ks[15], (DEPTH, W_A), 0.01),
        "lru_wx": nrm(ks[16], (DEPTH, N_LRU_HEADS, LRU_HEAD_DIM, LRU_HEAD_DIM), LRU_HEAD_DIM ** -0.5),
        "lru_bx": nrm(ks[17], (DEPTH, W_A), 0.01),
        "lru_lam": lru_lam,
        "pool_w": nrm(ks[18], (DEPTH, N_POOL_GROUPS, POOL_GROUP_DIM, POOL_GROUP_DIM), POOL_GROUP_DIM ** -0.5),
        "pool_scale": 1.0 + nrm(ks[19], (DEPTH, W_B), 0.1),
        "w_proj_a": nrm(ks[20], (DEPTH, W_A, D_MODEL), W_A ** -0.5),
        "w_proj_b": nrm(ks[21], (DEPTH, W_B, D_MODEL), W_B ** -0.5),
        "w_out": nrm(ks[22], (DEPTH, D_MODEL, D_MODEL), D_MODEL ** -0.5),
        "final_g": 1.0 + nrm(ks[23], (D_MODEL,), 0.05),
    }


def reference(x_prompt, x_sample, c_prompt, c_sample, state_conv, state_lru, state_pool,
              norm_g, w_ada, b_ada, w_in, conv_w, conv_b, lru_wa, lru_ba, lru_wx, lru_bx,
              lru_lam, pool_w, pool_scale, w_proj_a, w_proj_b, w_out, final_g):
    xp, xs = x_prompt, x_sample
    bp = x_prompt.shape[0]
    conv_p, lru_p, pool_p = [], [], []
    conv_s, lru_s, pool_s = [], [], []
    for l in range(DEPTH):
        wl = (norm_g[l], w_ada[l], b_ada[l], w_in[l], conv_w[l], conv_b[l], lru_wa[l], lru_ba[l],
              lru_wx[l], lru_bx[l], lru_lam[l], pool_w[l], pool_scale[l], w_proj_a[l], w_proj_b[l], w_out[l])
        xp, cb, hl, pb = layer(xp, c_prompt,
                               jnp.zeros((bp, CONV_WIDTH - 1, W_A), xp.dtype),
                               jnp.zeros((bp, W_A), jnp.float32),
                               jnp.zeros((bp, POOL_PAD, W_B), xp.dtype),
                               0, *wl)
        conv_p.append(cb); lru_p.append(hl); pool_p.append(pb)
        xs, cb, hl, pb = layer(xs, c_sample, state_conv[l], state_lru[l], state_pool[l],
                               PAST_LEN, *wl)
        conv_s.append(cb); lru_s.append(hl); pool_s.append(pb)
    y_prompt = rms_norm(xp, final_g)
    y_sample = rms_norm(xs, final_g)
    return (y_prompt, y_sample,
            jnp.stack(conv_p), jnp.stack(lru_p), jnp.stack(pool_p),
            jnp.stack(conv_s), jnp.stack(lru_s), jnp.stack(pool_s))
```

```cpp
#include <hip/hip_runtime.h>
#include <hip/hip_cooperative_groups.h>
#include <cstdio>
#include <cstdint>
namespace cg = cooperative_groups;

#define LAS __attribute__((address_space(3)))
typedef unsigned short bf16_t;
typedef unsigned int u32;
typedef short bf16x8 __attribute__((ext_vector_type(8)));
typedef float f32x4 __attribute__((ext_vector_type(4)));
typedef float f32x2 __attribute__((ext_vector_type(2)));
typedef unsigned u32x4 __attribute__((ext_vector_type(4)));
typedef unsigned u32x2 __attribute__((ext_vector_type(2)));

#ifndef N_LAUNCH_MODE
#define N_LAUNCH_MODE 1
#endif

constexpr int D = 2048, T = 34816, TP = 32768, NSTREAM = 34, DIN = 12288, NT = T / 256  ;
constexpr float EPS = 1e-6f;
constexpr size_t O_YP = 0, O_YS = 67108864, O_CP = 71303168, O_LP = 71327744, O_PP = 71335936, O_CS = 71458816, O_LS = 71852032, O_PS = 71983104;
constexpr size_t BUF_ELEMS = (size_t)T * D, BUF_BYTES = BUF_ELEMS * 2;
constexpr size_t WS_MOD = 4096, WS_AGG = (size_t)2 << 20, WS_HALO = (size_t)5 << 20, WS_WIN = (size_t)8 << 20;
constexpr size_t WIN_L = (size_t)DIN * D  , WCAT_L = (size_t)D * 4096, WO_L = (size_t)D * D, GT_L = (size_t)16 * 2 * 128 * 128, POOL_L = (size_t)D * 512;
constexpr size_t WS_WCAT = WS_WIN + 2 * WIN_L * 2, WS_WO = WS_WCAT + 2 * WCAT_L * 2, WS_GT = WS_WO + 2 * WO_L * 2, WS_POOL = WS_GT + 2 * GT_L * 2, WS_BUF = (size_t)160 << 20;
static_assert(WS_POOL + 2 * POOL_L * 2 <= WS_BUF, "weights overflow");
constexpr int LDS_BYTES = 136 * 1024;
constexpr int NPH = 16;

struct Params { const float* in[24]; float* out; unsigned char* ws; int ph_lo, ph_hi, coop, pad; };

__device__ __forceinline__ u32 pk_bf16(float lo, float hi) { u32 r; asm volatile("v_cvt_pk_bf16_f32 %0, %1, %2" : "=v"(r) : "v"(lo), "v"(hi)); return r; }
__device__ __forceinline__ float bflo(u32 u) { return __uint_as_float(u << 16); }
__device__ __forceinline__ float bfhi(u32 u) { return __uint_as_float(u & 0xffff0000u); }
__device__ __forceinline__ float sigm(float x) { return __builtin_amdgcn_rcpf(1.0f + __expf(-x)); }
__device__ __forceinline__ int stream_of_row(int row) { return row < TP ? (row >> 14) : 2 + ((row - TP) >> 6); }
__device__ __forceinline__ int otid() { int t = threadIdx.x; asm volatile("" : "+v"(t)); return t; }
__device__ __forceinline__ unsigned char* ows(unsigned char* p) { asm volatile("" : "+s"(p)); return p; }
struct F8 { float v[8]; };
__device__ __forceinline__ F8 unpack8(u32x4 w) { F8 r; r.v[0] = bflo(w.x); r.v[1] = bfhi(w.x); r.v[2] = bflo(w.y); r.v[3] = bfhi(w.y); r.v[4] = bflo(w.z); r.v[5] = bfhi(w.z); r.v[6] = bflo(w.w); r.v[7] = bfhi(w.w); return r; }
__device__ __forceinline__ u32x4 pack8(const F8& f) { u32x4 w; w.x = pk_bf16(f.v[0], f.v[1]); w.y = pk_bf16(f.v[2], f.v[3]); w.z = pk_bf16(f.v[4], f.v[5]); w.w = pk_bf16(f.v[6], f.v[7]); return w; }
__device__ __forceinline__ F8 ldf8(const float* p) { const f32x4 a = *(const f32x4*)p, b = *(const f32x4*)(p + 4); F8 r; r.v[0] = a[0]; r.v[1] = a[1]; r.v[2] = a[2]; r.v[3] = a[3]; r.v[4] = b[0]; r.v[5] = b[1]; r.v[6] = b[2]; r.v[7] = b[3]; return r; }
__device__ __forceinline__ void stf8(float* p, const F8& f) { *(f32x4*)p = (f32x4){f.v[0], f.v[1], f.v[2], f.v[3]}; *(f32x4*)(p + 4) = (f32x4){f.v[4], f.v[5], f.v[6], f.v[7]}; }

namespace pg8 {
constexpr int BM = 256, BK = 64, HALF = 128, HTB = HALF * BK * 2, STAGE_BYTES = 8 * HTB, NXCD = 8, WGM = 4;
__device__ __forceinline__ int lds_byte(int r, int c) { const int st = (r >> 4) * 2 + (c >> 5), rr = r & 15, cc = c & 31, ob = rr * 64 + cc * 2; return st * 1024 + (ob ^ (((ob >> 9) & 1) << 5)); }
__device__ __forceinline__ void stage_rc(int b, int& R, int& C) { const int st = b / 1024, sb = b % 1024, swz = sb ^ (((sb >> 9) & 1) << 5); R = (st >> 1) * 16 + swz / 64; C = (st & 1) * 32 + (swz % 64) / 2; }
__device__ __forceinline__ int perm32(int rho) { const int n = rho >> 4, i = rho & 15; return 8 * (i >> 2) + 4 * n + (i & 3); }
struct Unit { int pm, pn, r0, c0, mask; };
struct Gemm { const bf16_t* A; const bf16_t* Bt; const bf16_t* A2; };
struct StaticOrder {
    int nM, nN, nwg, G, c;
    __device__ void init(int M, int N, int G_, int c_) { nM = M / BM; nN = N / BM; nwg = nM * nN; G = G_; c = c_; }
    __device__ void locate(int L, Unit& u) const {
        int wgid = L; { const int q = nwg / NXCD, r = nwg % NXCD, xcd = wgid % NXCD, off = wgid / NXCD; wgid = (xcd < r ? xcd * (q + 1) : r * (q + 1) + (xcd - r) * q) + off; }
        const int nig = WGM * nN, gid = wgid / nig, fm = gid * WGM, gsz = (nM - fm) < WGM ? (nM - fm) : WGM;
        u.pm = fm + ((wgid % nig) % gsz); u.pn = (wgid % nig) / gsz; u.r0 = u.pm * BM; u.c0 = u.pn * BM; u.mask = 0xF;
    }
    __device__ bool quarter_tail() const { const int rem = nwg % G; return rem > 0 && rem * 4 <= G; }
    __device__ bool next(int i, Unit& u) const { const long L = (long)i * G + c; if (quarter_tail() ? i >= nwg / G : L >= nwg) return false; locate((int)L, u); return true; }
    __device__ int n_tail() const { return (quarter_tail() && (nwg % G) * 4 > c) ? 1 : 0; }
    __device__ void tail(int k, Unit& u) const { const int q = c + k * G; locate((nwg / G) * G + (q >> 2), u); u.r0 += ((q >> 1) & 1) * HALF; u.c0 += (q & 1) * HALF; u.mask = 1; }
};
template <class Epi, int K, int LDA, int LDB, int APN_SHIFT, int APN_ELEMS, int KSEG>
__device__ __forceinline__ void gemm_tail(LAS unsigned char* lds, const Gemm g, const Epi& E, const Unit u) {
    const int tid = otid(), wid = __builtin_amdgcn_readfirstlane(tid >> 6), lane = tid & 63, wr = wid >> 2, wc = wid & 3, fr = lane & 15, fq = lane >> 4;
    constexpr int nt = K / BK, nts = nt / KSEG;
    unsigned voffA[2], voffB[2];
#pragma unroll
    for (int i = 0; i < 2; ++i) { int R, C; stage_rc(tid * 16 + i * 8192, R, C); const int Rb = Epi::PERM ? ((R & ~31) + perm32(R & 31)) : R;
        voffA[i] = (unsigned)(R * LDA + C) * 2u; voffB[i] = (unsigned)(Rb * LDB + C) * 2u; }
    constexpr size_t kstep = (size_t)(BK * 2);
    const unsigned ldsw = (unsigned)wid * 1024u;
    const int aoff = lds_byte(wr * 64 + fr, fq * 8), boff = lds_byte(wc * 32 + fr, fq * 8);
    const char* gA = (const char*)g.A + ((size_t)u.r0 * LDA + (size_t)((u.pn >> APN_SHIFT) * APN_ELEMS)) * 2;
    const char* gA2 = KSEG == 2 ? (const char*)g.A2 + (size_t)u.r0 * LDA * 2 : gA;
    const char* gB = (const char*)g.Bt + (size_t)u.c0 * LDB * 2;
#define TL_STAGE(bufoff, gbase, voff) do { _Pragma("unroll") for (int _i = 0; _i < 2; ++_i) \
        __builtin_amdgcn_global_load_lds((const unsigned*)((const char*)(gbase) + (voff)[_i]), (LAS unsigned*)(lds + (bufoff) + ldsw + _i * 8192), 16, 0, 0); } while (0)
#define TL_LOAD(tt) do { const int _s = (tt) & 3; const char* _a = (KSEG == 2 && (tt) >= nts) ? gA2 + (size_t)((tt) - nts) * kstep : gA + (size_t)(tt) * kstep; \
        TL_STAGE((2 * _s) * HTB, _a, voffA); TL_STAGE((2 * _s + 1) * HTB, gB + (size_t)(tt) * kstep, voffB); } while (0)
    f32x4 acc[2][2][4][2];
#pragma unroll
    for (int a = 0; a < 2; ++a)
#pragma unroll
        for (int b = 0; b < 2; ++b)
#pragma unroll
            for (int m = 0; m < 4; ++m)
#pragma unroll
                for (int n = 0; n < 2; ++n) acc[a][b][m][n] = (f32x4){0.f, 0.f, 0.f, 0.f};
    TL_LOAD(0); TL_LOAD(1); TL_LOAD(2);
#pragma nounroll
    for (int t = 0; t < nt; ++t) {
        if constexpr (KSEG == 2) { if (t == nts) E.mid(acc, u, wr, wc, fr, fq); }
        const int rem = nt - t;
        if (rem >= 3) asm volatile("s_waitcnt vmcnt(8)" ::: "memory"); else if (rem == 2) asm volatile("s_waitcnt vmcnt(4)" ::: "memory"); else asm volatile("s_waitcnt vmcnt(0)" ::: "memory");
        __builtin_amdgcn_s_barrier();
        asm volatile("" ::: "memory");
        if (t + 3 < nt) TL_LOAD(t + 3);
        const int s = t & 3;
        bf16x8 At[4][2], Bf[2][2];
#pragma unroll
        for (int m = 0; m < 4; ++m)
#pragma unroll
            for (int k = 0; k < 2; ++k) At[m][k] = *(const LAS bf16x8*)(lds + (2 * s) * HTB + aoff + m * 2048 + k * 1024);
#pragma unroll
        for (int n = 0; n < 2; ++n)
#pragma unroll
            for (int k = 0; k < 2; ++k) Bf[n][k] = *(const LAS bf16x8*)(lds + (2 * s + 1) * HTB + boff + n * 2048 + k * 1024);
        asm volatile("s_waitcnt lgkmcnt(0)" ::: "memory");
#pragma unroll
        for (int m = 0; m < 4; ++m)
#pragma unroll
            for (int n = 0; n < 2; ++n)
#pragma unroll
                for (int k = 0; k < 2; ++k) acc[0][0][m][n] = __builtin_amdgcn_mfma_f32_16x16x32_bf16(Bf[n][k], At[m][k], acc[0][0][m][n], 0, 0, 0);
    }
    E(acc, u, wr, wc, fr, fq);
    asm volatile("s_waitcnt vmcnt(0)" ::: "memory");
    __builtin_amdgcn_s_barrier();
#undef TL_STAGE
#undef TL_LOAD
}
template <class Epi, int K, int LDA, int LDB, int APN_SHIFT, int APN_ELEMS, int KSEG = 1>
__device__ __forceinline__ void gemm_phase(LAS unsigned char* lds, const Gemm g, const StaticOrder& S, const Epi& E) {
    const int tid = otid(), wid = __builtin_amdgcn_readfirstlane(tid >> 6), lane = tid & 63, wr = wid >> 2, wc = wid & 3, fr = lane & 15, fq = lane >> 4;
    constexpr int nt = K / BK, nts = nt / KSEG;
    unsigned voffA[2], voffB[2];
#pragma unroll
    for (int i = 0; i < 2; ++i) { int R, C; stage_rc(tid * 16 + i * 8192, R, C); const int Rb = Epi::PERM ? ((R & ~31) + perm32(R & 31)) : R;
        voffA[i] = (unsigned)(R * LDA + C) * 2u; voffB[i] = (unsigned)(Rb * LDB + C) * 2u; }
    constexpr size_t kstep = (size_t)(BK * 2);
    constexpr size_t hstepA = (size_t)HALF * LDA * 2, hstepB = (size_t)HALF * LDB * 2;
    constexpr size_t tstepA = 2 * hstepA, tstepB = 2 * hstepB;
    const unsigned ldsw = (unsigned)wid * 1024u;
    const int aoff = lds_byte(wr * 64 + fr, fq * 8), boff = lds_byte(wc * 32 + fr, fq * 8);
#define PG8_SA(b, h) (((b) * 2 + (h)) * HTB)
#define PG8_SB(b, h) ((4 + (b) * 2 + (h)) * HTB)
#define PG8_STAGE(bufoff, gbase, voff) do { _Pragma("unroll") for (int _i = 0; _i < 2; ++_i) \
        __builtin_amdgcn_global_load_lds((const unsigned*)((const char*)(gbase) + (voff)[_i]), (LAS unsigned*)(lds + (bufoff) + ldsw + _i * 8192), 16, 0, 0); } while (0)
#define PG8_LDA(dst, b, h) do { _Pragma("unroll") for (int m = 0; m < 4; ++m) _Pragma("unroll") for (int k = 0; k < 2; ++k) dst[m][k] = *(const LAS bf16x8*)(lds + PG8_SA(b, h) + aoff + m * 2048 + k * 1024); } while (0)
#define PG8_LDB(dst, b, h) do { _Pragma("unroll") for (int n = 0; n < 2; ++n) _Pragma("unroll") for (int k = 0; k < 2; ++k) dst[n][k] = *(const LAS bf16x8*)(lds + PG8_SB(b, h) + boff + n * 2048 + k * 1024); } while (0)
#define PG8_MMA(ai, bj, At, Bt) do { __builtin_amdgcn_s_setprio(1); _Pragma("unroll") for (int m = 0; m < 4; ++m) _Pragma("unroll") for (int n = 0; n < 2; ++n) _Pragma("unroll") for (int k = 0; k < 2; ++k) \
        acc[ai][bj][m][n] = __builtin_amdgcn_mfma_f32_16x16x32_bf16(Bt[n][k], At[m][k], acc[ai][bj][m][n], 0, 0, 0); __builtin_amdgcn_s_setprio(0); } while (0)
#define PG8_WAIT_V(n) asm volatile("s_waitcnt vmcnt(" #n ")" ::: "memory")
#define PG8_WAIT_L(n) asm volatile("s_waitcnt lgkmcnt(" #n ")" ::: "memory")
#define PG8_BAR __builtin_amdgcn_s_barrier()
#define PG8_SCHED __builtin_amdgcn_sched_barrier(0)
    Unit cur, nxt; int ui = 0;
    if (!S.next(0, cur)) return;
    f32x4 acc[2][2][4][2];
#pragma unroll
    for (int a = 0; a < 2; ++a)
#pragma unroll
        for (int b = 0; b < 2; ++b)
#pragma unroll
            for (int m = 0; m < 4; ++m)
#pragma unroll
                for (int n = 0; n < 2; ++n) acc[a][b][m][n] = (f32x4){0.f, 0.f, 0.f, 0.f};
    bf16x8 At[4][2], B0[2][2], B1[2][2];
    const char* cA = (const char*)g.A + (size_t)cur.pm * tstepA + (size_t)((cur.pn >> APN_SHIFT) * APN_ELEMS) * 2; const char* cB = (const char*)g.Bt + (size_t)cur.pn * tstepB;
    const char* cA2 = KSEG == 2 ? (const char*)g.A2 + (size_t)cur.pm * tstepA : cA;
    PG8_STAGE(PG8_SB(0, 0), cB, voffB); PG8_STAGE(PG8_SB(0, 1), cB + hstepB, voffB); PG8_STAGE(PG8_SA(0, 0), cA, voffA); PG8_STAGE(PG8_SA(0, 1), cA + hstepA, voffA);
    if (wr == 1) PG8_BAR;
    PG8_WAIT_V(2); PG8_BAR;
    PG8_STAGE(PG8_SB(1, 0), cB + kstep, voffB); PG8_STAGE(PG8_SA(1, 0), cA + kstep, voffA); PG8_STAGE(PG8_SB(1, 1), cB + hstepB + kstep, voffB);
    PG8_WAIT_V(6); PG8_BAR;
    for (;;) {
        const bool has_next = S.next(ui + 1, nxt);
        const char* nA = has_next ? (const char*)g.A + (size_t)nxt.pm * tstepA + (size_t)((nxt.pn >> APN_SHIFT) * APN_ELEMS) * 2 : cA; const char* nB = has_next ? (const char*)g.Bt + (size_t)nxt.pn * tstepB : cB;
        for (int t = 0; t < nt; t += 2) {
            const bool last = (t == nt - 2);
            const char* a1 = (KSEG == 2 && t >= nts) ? cA2 + (size_t)(t + 1 - nts) * kstep : cA + (size_t)(t + 1) * kstep;
            const char* a2 = last ? nA : ((KSEG == 2 && t + 2 >= nts) ? cA2 + (size_t)(t + 2 - nts) * kstep : cA + (size_t)(t + 2) * kstep); const char* b2 = last ? nB : cB + (size_t)(t + 2) * kstep;
            const char* a3 = a2 + kstep; const char* b3 = b2 + kstep;
            if constexpr (KSEG == 2) { if (t == nts) E.mid(acc, cur, wr, wc, fr, fq); }
            PG8_LDB(B0, 0, 0); PG8_LDB(B1, 0, 1); PG8_SCHED; PG8_LDA(At, 0, 0); PG8_STAGE(PG8_SA(1, 1), a1 + hstepA, voffA);
            PG8_WAIT_V(8); PG8_WAIT_L(0); PG8_BAR; PG8_MMA(0, 0, At, B0); PG8_MMA(0, 1, At, B1); PG8_BAR; PG8_SCHED;
            PG8_LDA(At, 0, 1); PG8_STAGE(PG8_SB(0, 0), b2, voffB); PG8_STAGE(PG8_SB(0, 1), b2 + hstepB, voffB); PG8_STAGE(PG8_SA(0, 0), a2, voffA);
            PG8_WAIT_V(8); PG8_WAIT_L(0); PG8_BAR; PG8_MMA(1, 0, At, B0); PG8_MMA(1, 1, At, B1); PG8_BAR; PG8_SCHED;
            PG8_LDB(B0, 1, 0); PG8_LDB(B1, 1, 1); PG8_SCHED; PG8_LDA(At, 1, 0); PG8_STAGE(PG8_SA(0, 1), a2 + hstepA, voffA);
            PG8_WAIT_V(8); PG8_WAIT_L(0); PG8_BAR; PG8_MMA(0, 0, At, B0); PG8_MMA(0, 1, At, B1); PG8_BAR; PG8_SCHED;
            PG8_LDA(At, 1, 1); PG8_STAGE(PG8_SB(1, 0), b3, voffB); PG8_STAGE(PG8_SB(1, 1), b3 + hstepB, voffB); PG8_STAGE(PG8_SA(1, 0), a3, voffA);
            PG8_WAIT_V(8); PG8_WAIT_L(0); PG8_BAR; PG8_MMA(1, 0, At, B0); PG8_MMA(1, 1, At, B1); PG8_BAR; PG8_SCHED;
        }
        if (wr == 0) PG8_BAR;
        E(acc, cur, wr, wc, fr, fq);
        if (!has_next) break;
#pragma unroll
        for (int a = 0; a < 2; ++a)
#pragma unroll
            for (int b = 0; b < 2; ++b)
#pragma unroll
                for (int m = 0; m < 4; ++m)
#pragma unroll
                    for (int n = 0; n < 2; ++n) acc[a][b][m][n] = (f32x4){0.f, 0.f, 0.f, 0.f};
        cur = nxt; cA = nA; cB = nB; ++ui;
        if constexpr (KSEG == 2) cA2 = (const char*)g.A2 + (size_t)cur.pm * tstepA;
        if (wr == 1) PG8_BAR;
    }
    PG8_WAIT_V(0);
    PG8_BAR;
    for (int k = 0; k < S.n_tail(); ++k) { Unit tu; S.tail(k, tu); gemm_tail<Epi, K, LDA, LDB, APN_SHIFT, APN_ELEMS, KSEG>(lds, g, E, tu); }
#undef PG8_SA
#undef PG8_SB
#undef PG8_STAGE
#undef PG8_LDA
#undef PG8_LDB
#undef PG8_MMA
#undef PG8_WAIT_V
#undef PG8_WAIT_L
#undef PG8_BAR
#undef PG8_SCHED
}
}
using pg8::Unit;

struct EpiAct {
    static constexpr bool PERM = true;
    bf16_t* base; long tstride; int act0, act1; bf16_t* halo;
    __device__ __forceinline__ void operator()(const f32x4 (&acc)[2][2][4][2], const Unit& u, int wr, int wc, int fr, int fq) const {
        const int colt = u.c0, t = colt >> 11, lc = colt & 2047, act = (t & 1) ? act1 : act0;
        bf16_t* dst = base + (long)t * tstride;
        const int col0 = lc + wc * 32 + 8 * fq, row0 = u.r0 + wr * 64 + fr;
#pragma unroll
        for (int ai = 0; ai < 2; ++ai)
#pragma unroll
            for (int m = 0; m < 4; ++m) { bf16_t* rowp = dst + (size_t)(row0 + ai * 128 + m * 16) * D + col0;
#pragma unroll
                for (int bj = 0; bj < 2; ++bj) { if (!((u.mask >> (ai * 2 + bj)) & 1)) continue; f32x4 v0 = acc[ai][bj][m][0], v1 = acc[ai][bj][m][1];
                    if (act == 1) {
#pragma unroll
                        for (int j = 0; j < 4; ++j) { v0[j] = v0[j] * sigm(v0[j]); v1[j] = v1[j] * sigm(v1[j]); } }
                    else if (act == 2) {
#pragma unroll
                        for (int j = 0; j < 4; ++j) { v0[j] = sigm(v0[j]); v1[j] = sigm(v1[j]); } }
                    u32x4 w; w.x = pk_bf16(v0[0], v0[1]); w.y = pk_bf16(v0[2], v0[3]); w.z = pk_bf16(v1[0], v1[1]); w.w = pk_bf16(v1[2], v1[3]);
                    *(u32x4*)(rowp + bj * 128) = w;
                    if (halo && t == 0 && ai == 1 && wr == 1 && m == 3 && fr >= 13) *(u32x4*)(halo + (size_t)(u.pm * 3 + fr - 13) * D + col0 + bj * 128) = w;
                } }
    }
};
struct EpiPool {
    static constexpr bool PERM = true;
    bf16_t* gb; const float* scale;
    __device__ __forceinline__ void operator()(const f32x4 (&acc)[2][2][4][2], const Unit& u, int wr, int wc, int fr, int fq) const {
        const int col0 = u.c0 + wc * 32 + 8 * fq, row0 = u.r0 + wr * 64 + fr;
        f32x4 sc[2][2];
#pragma unroll
        for (int bj = 0; bj < 2; ++bj)
#pragma unroll
            for (int n = 0; n < 2; ++n) sc[bj][n] = *(const f32x4*)(scale + col0 + bj * 128 + 4 * n);
#pragma unroll
        for (int ai = 0; ai < 2; ++ai)
#pragma unroll
            for (int m = 0; m < 4; ++m) { bf16_t* rowp = gb + (size_t)(row0 + ai * 128 + m * 16) * D + col0;
#pragma unroll
                for (int bj = 0; bj < 2; ++bj) { if (!((u.mask >> (ai * 2 + bj)) & 1)) continue; const u32x4 gq = *(const u32x4*)(rowp + bj * 128);
                    const f32x4 v0 = acc[ai][bj][m][0] * sc[bj][0], v1 = acc[ai][bj][m][1] * sc[bj][1];
                    u32x4 w; w.x = pk_bf16(v0[0] * bflo(gq.x), v0[1] * bfhi(gq.x)); w.y = pk_bf16(v0[2] * bflo(gq.y), v0[3] * bfhi(gq.y));
                    w.z = pk_bf16(v1[0] * bflo(gq.z), v1[1] * bfhi(gq.z)); w.w = pk_bf16(v1[2] * bflo(gq.w), v1[3] * bfhi(gq.w));
                    *(u32x4*)(rowp + bj * 128) = w; } }
    }
};
struct EpiGate2 {
    static constexpr bool PERM = true;
    const bf16_t* ga; const bf16_t* gb; bf16_t* dst;
    __device__ __forceinline__ void mid(f32x4 (&acc)[2][2][4][2], const Unit& u, int wr, int wc, int fr, int fq) const {
        int frv = fr; asm volatile("" : "+v"(frv));
        const int col0 = u.c0 + wc * 32 + 8 * fq, row0 = u.r0 + wr * 64 + frv;
#pragma unroll
        for (int ai = 0; ai < 2; ++ai) {
            if (!((u.mask >> (ai * 2)) & 3)) continue;
            u32x4 ra[4][2], rb[4][2];
#pragma unroll
            for (int m = 0; m < 4; ++m) { const size_t off = (size_t)(row0 + ai * 128 + m * 16) * D + col0;
#pragma unroll
                for (int bj = 0; bj < 2; ++bj) { if (!((u.mask >> (ai * 2 + bj)) & 1)) continue; ra[m][bj] = *(const u32x4*)(ga + off + bj * 128); rb[m][bj] = *(const u32x4*)(gb + off + bj * 128); } }
#pragma unroll
            for (int m = 0; m < 4; ++m)
#pragma unroll
                for (int bj = 0; bj < 2; ++bj) { if (!((u.mask >> (ai * 2 + bj)) & 1)) continue;
                    const F8 fa = unpack8(ra[m][bj]), fb = unpack8(rb[m][bj]);
#pragma unroll
                    for (int j = 0; j < 4; ++j) { acc[ai][bj][m][0][j] *= fa.v[j] * __builtin_amdgcn_rcpf(fmaxf(fb.v[j], 1e-20f)); acc[ai][bj][m][1][j] *= fa.v[4 + j] * __builtin_amdgcn_rcpf(fmaxf(fb.v[4 + j], 1e-20f)); } }
            asm volatile("" ::: "memory");
        }
    }
    __device__ __forceinline__ void operator()(const f32x4 (&acc)[2][2][4][2], const Unit& u, int wr, int wc, int fr, int fq) const {
        const int col0 = u.c0 + wc * 32 + 8 * fq, row0 = u.r0 + wr * 64 + fr;
#pragma unroll
        for (int ai = 0; ai < 2; ++ai)
#pragma unroll
            for (int m = 0; m < 4; ++m) { const size_t off = (size_t)(row0 + ai * 128 + m * 16) * D + col0;
#pragma unroll
                for (int bj = 0; bj < 2; ++bj) { if (!((u.mask >> (ai * 2 + bj)) & 1)) continue; const F8 fb = unpack8(*(const u32x4*)(gb + off + bj * 128));
                    const f32x4 a0 = acc[ai][bj][m][0], a1 = acc[ai][bj][m][1]; F8 o;
#pragma unroll
                    for (int j = 0; j < 4; ++j) { o.v[j] = a0[j] * fmaxf(fb.v[j], 1e-20f); o.v[4 + j] = a1[j] * fmaxf(fb.v[4 + j], 1e-20f); }
                    *(u32x4*)(dst + off + bj * 128) = pack8(o); } }
    }
};
struct EpiRes {
    static constexpr bool PERM = false;
    const float* xp; const float* xs; float* out; const float* mod;
    __device__ __forceinline__ void operator()(const f32x4 (&acc)[2][2][4][2], const Unit& u, int wr, int wc, int fr, int fq) const {
        const int col0 = u.c0 + wc * 32 + 4 * fq;
#pragma unroll
        for (int ai = 0; ai < 2; ++ai) {
            if (!((u.mask >> (ai * 2)) & 3)) continue;
            const int rb = u.r0 + ai * 128 + wr * 64, st = stream_of_row(rb);
            const float* gp = mod + (size_t)st * 6144 + 4096 + col0;
            f32x4 gv[2][2];
#pragma unroll
            for (int bj = 0; bj < 2; ++bj)
#pragma unroll
                for (int n = 0; n < 2; ++n) gv[bj][n] = *(const f32x4*)(gp + bj * 128 + n * 16);
            const float* xb = rb < TP ? xp + (size_t)rb * D : xs + (size_t)(rb - TP) * D;
            f32x4 xo[4][2][2];
#pragma unroll
            for (int m = 0; m < 4; ++m) { const size_t ro = (size_t)(m * 16 + fr) * D + col0;
#pragma unroll
                for (int bj = 0; bj < 2; ++bj) { if (!((u.mask >> (ai * 2 + bj)) & 1)) continue;
#pragma unroll
                    for (int n = 0; n < 2; ++n) xo[m][bj][n] = *(const f32x4*)(xb + ro + bj * 128 + n * 16); } }
#pragma unroll
            for (int m = 0; m < 4; ++m) { const size_t ro = (size_t)(m * 16 + fr) * D + col0;
#pragma unroll
                for (int bj = 0; bj < 2; ++bj) { if (!((u.mask >> (ai * 2 + bj)) & 1)) continue;
#pragma unroll
                    for (int n = 0; n < 2; ++n) *(f32x4*)(out + (size_t)rb * D + ro + bj * 128 + n * 16) = xo[m][bj][n] + gv[bj][n] * acc[ai][bj][m][n]; } }
        }
    }
};

__device__ void mod_phase(const Params& P, LAS unsigned char* lds) {
    LAS float* sc = (LAS float*)lds;
    LAS float* red = (LAS float*)(lds + 40960);
    const int tid = otid(), wid = tid >> 6, lane = tid & 63;
    float* MOD = (float*)(ows(P.ws) + WS_MOD);
    for (int item = blockIdx.x; item < 192; item += gridDim.x) {
        const int l = item / 96, jb = item % 96;
        const float* W = P.in[8] + (size_t)l * D * 6144 + jb * 64 + lane;
        float acc[36];
#pragma unroll
        for (int s = 0; s < 36; ++s) acc[s] = 0.f;
        for (int kc = 0; kc < 8; ++kc) {
            __syncthreads();
            for (int i = tid; i < 256 * 34; i += 512) { const int k = i & 255, s = i >> 8; const float c = s < 2 ? P.in[2][s * D + kc * 256 + k] : P.in[3][(s - 2) * D + kc * 256 + k]; sc[k * 36 + s] = c * sigm(c); }
            if (tid < 256) { sc[tid * 36 + 34] = 0.f; sc[tid * 36 + 35] = 0.f; }
            __syncthreads();
#pragma unroll 8
            for (int kk = 0; kk < 32; ++kk) { const int k = wid * 32 + kk; const float w = W[(size_t)(kc * 256 + k) * 6144];
#pragma unroll
                for (int s4 = 0; s4 < 9; ++s4) { const f32x4 c4 = *(const LAS f32x4*)(sc + k * 36 + s4 * 4); acc[s4 * 4] += c4[0] * w; acc[s4 * 4 + 1] += c4[1] * w; acc[s4 * 4 + 2] += c4[2] * w; acc[s4 * 4 + 3] += c4[3] * w; } }
        }
#pragma unroll
        for (int s = 0; s < 34; ++s) red[(wid * 34 + s) * 64 + lane] = acc[s];
        __syncthreads();
        for (int i = tid; i < 34 * 64; i += 512) { float v = 0.f;
#pragma unroll
            for (int w = 0; w < 8; ++w) v += red[w * 34 * 64 + i];
            const int s = i >> 6, j = jb * 64 + (i & 63); MOD[(size_t)(l * 34 + s) * 6144 + j] = v + P.in[9][l * 6144 + j]; }
    }
    __syncthreads();
}
struct TDesc { const float* src; bf16_t* dst; int N, ldd; };
__device__ __forceinline__ TDesc tile_desc(const Params& P, unsigned char* ws, int item) {
    const int l = item / 4800; int r = item % 4800;
    const float* src; bf16_t* dst; int K, N, ldd;
    if (r < 3072) { src = P.in[10] + (size_t)l * D * DIN; dst = (bf16_t*)(ws + WS_WIN) + l * WIN_L; K = D; N = DIN; ldd = D; }
    else if (r < 3584) { r -= 3072; src = P.in[20] + (size_t)l * D * D; dst = (bf16_t*)(ws + WS_WCAT) + l * WCAT_L; K = D; N = D; ldd = 4096; }
    else if (r < 4096) { r -= 3584; src = P.in[21] + (size_t)l * D * D; dst = (bf16_t*)(ws + WS_WCAT) + l * WCAT_L + 2048; K = D; N = D; ldd = 4096; }
    else if (r < 4608) { r -= 4096; src = P.in[22] + (size_t)l * D * D; dst = (bf16_t*)(ws + WS_WO) + l * WO_L; K = D; N = D; ldd = D; }
    else if (r < 4640) { r -= 4608; const int h = r >> 1; r &= 1; src = P.in[13] + (size_t)(l * 16 + h) * 16384; dst = (bf16_t*)(ws + WS_GT) + l * GT_L + (size_t)(h * 2 + 0) * 16384; K = 128; N = 128; ldd = 128; }
    else if (r < 4672) { r -= 4640; const int h = r >> 1; r &= 1; src = P.in[15] + (size_t)(l * 16 + h) * 16384; dst = (bf16_t*)(ws + WS_GT) + l * GT_L + (size_t)(h * 2 + 1) * 16384; K = 128; N = 128; ldd = 128; }
    else { r -= 4672; const int gi = r >> 5; r &= 31; src = P.in[18] + (size_t)(l * 4 + gi) * 262144; dst = (bf16_t*)(ws + WS_POOL) + l * POOL_L + (size_t)gi * 262144; K = 512; N = 512; ldd = 512; }
    (void)K;
    const int ntn = N / 64, nt = r % ntn, kt = r / ntn, k0 = kt * 128, n0 = nt * 64;
    TDesc d; d.src = src + (size_t)k0 * N + n0; d.dst = dst + (size_t)n0 * ldd + k0; d.N = N; d.ldd = ldd; return d;
}
__device__ void transpose_phase(const Params& P, LAS unsigned char* lds) {
    LAS float* tl = (LAS float*)lds;
    const int tid = otid(); unsigned char* ws = ows(P.ws);
    const int G = gridDim.x;
    int item = blockIdx.x;
    f32x4 v[4];
    { const TDesc d = tile_desc(P, ws, item); const float* sp = d.src + (size_t)(tid >> 4) * d.N + (tid & 15) * 4;
#pragma unroll
      for (int p = 0; p < 4; ++p) v[p] = *(const f32x4*)(sp + (size_t)(p * 32) * d.N); }
#pragma nounroll
    for (; item < 9600; item += G) {
#pragma unroll
        for (int p = 0; p < 4; ++p) { const int k = p * 32 + (tid >> 4), n4 = (tid & 15) * 4; tl[k * 65 + n4] = v[p][0]; tl[k * 65 + n4 + 1] = v[p][1]; tl[k * 65 + n4 + 2] = v[p][2]; tl[k * 65 + n4 + 3] = v[p][3]; }
        __syncthreads();
        if (item + G < 9600) { const TDesc d = tile_desc(P, ws, item + G); const float* sp = d.src + (size_t)(tid >> 4) * d.N + (tid & 15) * 4;
#pragma unroll
            for (int p = 0; p < 4; ++p) v[p] = *(const f32x4*)(sp + (size_t)(p * 32) * d.N); }
        { const TDesc c = tile_desc(P, ws, item);
#pragma unroll
          for (int p = 0; p < 2; ++p) { const int n = p * 32 + (tid >> 4), k8 = (tid & 15) * 8; F8 f;
#pragma unroll
            for (int j = 0; j < 8; ++j) f.v[j] = tl[(k8 + j) * 65 + n];
            *(u32x4*)(c.dst + (size_t)n * c.ldd + k8) = pack8(f); } }
        __syncthreads();
    }
}
__device__ void norm_phase(const Params& P, int l, bool final_) {
    const int tid = otid(), wid = tid >> 6, lane = tid & 63; unsigned char* ws = ows(P.ws);
    bf16_t* H = (bf16_t*)(ws + WS_BUF);
    const float* MOD = (const float*)(ws + WS_MOD);
    for (int row = blockIdx.x * 8 + wid; row < T; row += gridDim.x * 8) {
        const float* x = (l == 0 && !final_) ? (row < TP ? P.in[0] + (size_t)row * D : P.in[1] + (size_t)(row - TP) * D) : P.out + (size_t)row * D;
        const float* mp = MOD + (size_t)(l * 34 + stream_of_row(row)) * 6144;
        const float* gp = final_ ? P.in[23] : P.in[7] + l * D;
        f32x4 v[8], g[8], sh[8], sc[8];
#pragma unroll
        for (int j = 0; j < 8; ++j) v[j] = *(const f32x4*)(x + (lane + 64 * j) * 4);
#pragma unroll
        for (int j = 0; j < 8; ++j) g[j] = *(const f32x4*)(gp + (lane + 64 * j) * 4);
        if (!final_) {
#pragma unroll
            for (int j = 0; j < 8; ++j) { sh[j] = *(const f32x4*)(mp + (lane + 64 * j) * 4); sc[j] = *(const f32x4*)(mp + 2048 + (lane + 64 * j) * 4); }
        }
        float ss = 0.f;
#pragma unroll
        for (int j = 0; j < 8; ++j) ss += v[j][0] * v[j][0] + v[j][1] * v[j][1] + v[j][2] * v[j][2] + v[j][3] * v[j][3];
#pragma unroll
        for (int o = 32; o >= 1; o >>= 1) ss += __shfl_xor(ss, o);
        const float rstd = rsqrtf(ss * (1.0f / D) + EPS);
        if (final_) {
#pragma unroll
            for (int j = 0; j < 8; ++j) *(f32x4*)(P.out + (size_t)row * D + (lane + 64 * j) * 4) = v[j] * rstd * g[j];
        } else {
#pragma unroll
            for (int j = 0; j < 8; ++j) { const f32x4 h = v[j] * rstd * g[j] * (1.0f + sc[j]) + sh[j]; u32x2 w; w.x = pk_bf16(h[0], h[1]); w.y = pk_bf16(h[2], h[3]); *(u32x2*)(H + (size_t)row * D + (lane + 64 * j) * 4) = w; }
        }
    }
}
__device__ __forceinline__ void a_unit(const Params& P, LAS unsigned char* lds0, int l, int pm, int h, int par) {
    LAS unsigned char* lds = lds0 + par * 65536;
    const int tid = otid(), wid = __builtin_amdgcn_readfirstlane(tid >> 6), lane = tid & 63, fr = lane & 15, fq = lane >> 4; unsigned char* ws = ows(P.ws);
    bf16_t* XA = (bf16_t*)(ws + WS_BUF + 1 * BUF_BYTES); bf16_t* GA = (bf16_t*)(ws + WS_BUF + 2 * BUF_BYTES);
    const bf16_t* HALO = (const bf16_t*)(ws + WS_HALO);
    const bool is_sample = pm >= 128;
    const int chl = 16 * wid + 4 * fq, chg = h * 128 + chl;
    bf16x8 bfr[2][4];
    { const bf16_t* GT = (const bf16_t*)(ws + WS_GT) + l * GT_L + (size_t)(h * 2) * 16384 + (size_t)(16 * wid + fr) * 128 + 8 * fq;
#pragma unroll
      for (int g = 0; g < 2; ++g)
#pragma unroll
          for (int ks = 0; ks < 4; ++ks) bfr[g][ks] = *(const bf16x8*)(GT + g * 16384 + ks * 32); }
    const f32x4 ba = *(const f32x4*)(P.in[14] + (size_t)l * D + chg), bx = *(const f32x4*)(P.in[16] + (size_t)l * D + chg), lam = *(const f32x4*)(P.in[17] + (size_t)l * D + chg);
    {
        const int chunk = tid & 15, ch0 = h * 128 + chunk * 8, r0 = (tid >> 4) * 8;
        const int tpos0 = is_sample ? (r0 & 63) : ((pm & 63) * 256 + r0);
        F8 xw[11];
#pragma unroll
        for (int j = 0; j < 11; ++j) {
            const int rr = r0 + j - 3, tp = tpos0 + j - 3;
            if (tp < 0) {
                if (is_sample) xw[j] = ldf8(P.in[4] + ((size_t)(l * 32 + (pm - 128) * 4 + (r0 >> 6)) * 3 + (3 + tp)) * D + ch0);
                else {
#pragma unroll
                    for (int i = 0; i < 8; ++i) xw[j].v[i] = 0.f; }
            } else if (rr < 0) xw[j] = unpack8(*(const u32x4*)(HALO + (size_t)((pm - 1) * 3 + 3 + rr) * D + ch0));
            else xw[j] = unpack8(*(const u32x4*)(XA + (size_t)(pm * 256 + rr) * D + ch0));
        }
        const F8 w0 = ldf8(P.in[11] + (size_t)(l * 4 + 0) * D + ch0), w1 = ldf8(P.in[11] + (size_t)(l * 4 + 1) * D + ch0), w2 = ldf8(P.in[11] + (size_t)(l * 4 + 2) * D + ch0), w3 = ldf8(P.in[11] + (size_t)(l * 4 + 3) * D + ch0), cb = ldf8(P.in[12] + (size_t)l * D + ch0);
#pragma unroll
        for (int j = 0; j < 8; ++j) {
            const int row = r0 + j; F8 y;
#pragma unroll
            for (int i = 0; i < 8; ++i) y.v[i] = cb.v[i] + w0.v[i] * xw[j].v[i] + w1.v[i] * xw[j + 1].v[i] + w2.v[i] * xw[j + 2].v[i] + w3.v[i] * xw[j + 3].v[i];
            *(LAS u32x4*)(lds + row * 256 + ((chunk ^ (row >> 4)) & 15) * 16) = pack8(y);
            if (j >= 5) {
                if (is_sample) { if ((r0 & 63) == 56) stf8(P.out + O_CS + ((size_t)(l * 32 + (pm - 128) * 4 + (r0 >> 6)) * 3 + j - 5) * D + ch0, xw[j + 3]); }
                else if ((pm & 63) == 63 && r0 == 248) stf8(P.out + O_CP + ((size_t)(l * 2 + (pm >> 6)) * 3 + j - 5) * D + ch0, xw[j + 3]);
            }
        }
    }
    __syncthreads();
    f32x4 ar[16], ai_[16];
    {
#pragma unroll
        for (int m = 0; m < 16; ++m) { ar[m] = (f32x4){0.f, 0.f, 0.f, 0.f}; ai_[m] = (f32x4){0.f, 0.f, 0.f, 0.f}; }
#pragma unroll
        for (int m = 0; m < 16; ++m) {
#pragma unroll
            for (int ks = 0; ks < 4; ++ks) { const bf16x8 af = *(const LAS bf16x8*)(lds + (16 * fr + m) * 256 + (((4 * ks + fq) ^ fr) & 15) * 16);
                ar[m] = __builtin_amdgcn_mfma_f32_16x16x32_bf16(bfr[0][ks], af, ar[m], 0, 0, 0);
                ai_[m] = __builtin_amdgcn_mfma_f32_16x16x32_bf16(bfr[1][ks], af, ai_[m], 0, 0, 0); } }
    }
    f32x4 nsp2, nspx, bal, bxl;
#pragma unroll
    for (int j = 0; j < 4; ++j) { const float z = -lam[j]; const float nsp = -8.0f * (z > 15.f ? z : log1pf(__expf(z))); nsp2[j] = nsp * 1.44269504f; nspx[j] = 2.0f * nsp; bal[j] = ba[j] * -1.44269504f; bxl[j] = bx[j] * -1.44269504f; }
    f32x4 Ap = (f32x4){1.f, 1.f, 1.f, 1.f}, Bp = (f32x4){0.f, 0.f, 0.f, 0.f};
    const int xoff = ((((chl >> 3) ^ fr) & 15) * 16) + (fq & 1) * 8;
#pragma unroll
    for (int m = 0; m < 16; ++m) {
        const u32x2 xw = *(const LAS u32x2*)(lds + (16 * fr + m) * 256 + xoff);
        const float xc[4] = {bflo(xw.x), bfhi(xw.x), bflo(xw.y), bfhi(xw.y)};
#pragma unroll
        for (int j = 0; j < 4; ++j) {
            const float r = __builtin_amdgcn_rcpf(1.0f + __builtin_amdgcn_exp2f(ar[m][j] * -1.44269504f + bal[j]));
            const float ig = __builtin_amdgcn_rcpf(1.0f + __builtin_amdgcn_exp2f(ai_[m][j] * -1.44269504f + bxl[j]));
            const float a = __builtin_amdgcn_exp2f(nsp2[j] * r), x = nspx[j] * r;
            const float tay = -x * (1.0f + x * (0.5f + x * (0.16666667f + x * (0.041666668f + x * (0.0083333338f + x * 0.0013888889f)))));
            const float em = x > -0.25f ? tay : 1.0f - a * a;
            const float mult = __builtin_amdgcn_sqrtf(fmaxf(em, 0.f));
            const float uu = mult * ig * xc[j];
            Bp[j] = a * Bp[j] + uu; Ap[j] = a * Ap[j];
            ar[m][j] = Ap[j]; ai_[m][j] = Bp[j];
        }
    }
    const int frs = is_sample ? (fr & 3) : fr;
    f32x4 IA = Ap, IB = Bp;
#pragma unroll
    for (int s = 1; s < 16; s <<= 1) {
        f32x4 pa, pb;
#pragma unroll
        for (int j = 0; j < 4; ++j) { pa[j] = __shfl_up(IA[j], s, 16); pb[j] = __shfl_up(IB[j], s, 16); }
        if (frs >= s) {
#pragma unroll
            for (int j = 0; j < 4; ++j) { IB[j] = IA[j] * pb[j] + IB[j]; IA[j] = IA[j] * pa[j]; } }
    }
    f32x4 EA, EB;
#pragma unroll
    for (int j = 0; j < 4; ++j) { EA[j] = __shfl_up(IA[j], 1, 16); EB[j] = __shfl_up(IB[j], 1, 16); }
    if (frs == 0) { EA = (f32x4){1.f, 1.f, 1.f, 1.f}; EB = (f32x4){0.f, 0.f, 0.f, 0.f}; }
    {
        float* AGG = (float*)(ws + WS_AGG);
        const bool lastl = is_sample ? ((fr & 3) == 3) : (fr == 15);
        if (lastl) { const int chunk = is_sample ? 128 + (pm - 128) * 4 + (fr >> 2) : pm; float* ap = AGG + ((size_t)chunk * D + chg) * 2;
            *(f32x4*)ap = (f32x4){IA[0], IB[0], IA[1], IB[1]}; *(f32x4*)(ap + 4) = (f32x4){IA[2], IB[2], IA[3], IB[3]}; }
    }
    u32x2 sgw[16];
    int frz = fr; asm volatile("" : "+v"(frz) : "v"(EA[0]));
#pragma unroll
    for (int m = 0; m < 16; ++m) sgw[m] = *(const u32x2*)(GA + (size_t)(pm * 256 + 16 * frz + m) * D + chg);
#pragma unroll
    for (int m = 0; m < 16; ++m) {
        const size_t off = (size_t)(pm * 256 + 16 * fr + m) * D + chg;
        const u32x2 sw = sgw[m];
        const float sg[4] = {bflo(sw.x), bfhi(sw.x), bflo(sw.y), bfhi(sw.y)};
        float pv[4], qv[4];
#pragma unroll
        for (int j = 0; j < 4; ++j) { const float acum = EA[j] * ar[m][j], hloc = ar[m][j] * EB[j] + ai_[m][j]; pv[j] = hloc * sg[j]; qv[j] = acum * sg[j]; }
        u32x2 pw, qw; pw.x = pk_bf16(pv[0], pv[1]); pw.y = pk_bf16(pv[2], pv[3]); qw.x = pk_bf16(qv[0], qv[1]); qw.y = pk_bf16(qv[2], qv[3]);
        *(u32x2*)(XA + off) = pw; *(u32x2*)(GA + off) = qw;
    }
}
template <int W, int R>
__device__ __forceinline__ void pool_block(const Params& P, const bf16_t* XB, bf16_t* DB, int l, int token0, int g, int lane) {
    const int ch0 = g * 512 + lane * 8;
    const bool smp = token0 >= TP;
    const int sidx = smp ? (token0 - TP) >> 6 : token0 >> 14, tpos0 = smp ? (token0 - TP) & 63 : token0 & 16383;
    u32x4 raw[R + W - 1];
#pragma unroll
    for (int i = 0; i < R + W - 1; ++i) {
        const int r = i - (W - 1), tp = tpos0 + r;
        if (tp >= 0) raw[i] = *(const u32x4*)(XB + (size_t)(token0 + r) * D + ch0);
        else if (smp) raw[i] = pack8(ldf8(P.in[6] + ((size_t)(l * 32 + sidx) * 15 + (15 + tp)) * D + ch0));
        else raw[i] = (u32x4){0u, 0u, 0u, 0u};
    }
    F8 sum;
#pragma unroll
    for (int i = 0; i < 8; ++i) sum.v[i] = 0.f;
#pragma unroll
    for (int i = 0; i < W - 1; ++i) { const F8 x = unpack8(raw[i]);
#pragma unroll
        for (int k = 0; k < 8; ++k) sum.v[k] += x.v[k]; }
#pragma unroll
    for (int r = 0; r < R; ++r) {
        const F8 x = unpack8(raw[r + W - 1]), xo = unpack8(raw[r]);
        const int tp = tpos0 + r; const float ic = 1.0f / (smp ? (float)W : (float)(W < tp + 1 ? W : tp + 1));
        F8 d;
#pragma unroll
        for (int k = 0; k < 8; ++k) { sum.v[k] += x.v[k]; d.v[k] = sum.v[k] * ic - x.v[k]; sum.v[k] -= xo.v[k]; }
        *(u32x4*)(DB + (size_t)(token0 + r) * D + ch0) = pack8(d);
        if (smp) { if (tp >= 49) stf8(P.out + O_PS + ((size_t)(l * 32 + sidx) * 15 + tp - 49) * D + ch0, x); }
        else if (tp >= 16369) stf8(P.out + O_PP + ((size_t)(l * 2 + sidx) * 15 + tp - 16369) * D + ch0, x);
    }
}
__device__ void pool_pass(const Params& P, int l) {
    const int tid = otid(), wid = __builtin_amdgcn_readfirstlane(tid >> 6), lane = tid & 63; unsigned char* ws = ows(P.ws);
    const bf16_t* XB = (const bf16_t*)(ws + WS_BUF + 3 * BUF_BYTES); bf16_t* DB = (bf16_t*)(ws + WS_BUF + 5 * BUF_BYTES);
    const int G = gridDim.x, nbig = (NT * 16) % G, nsmall = nbig ? G - nbig : 0, nx = nsmall * 8 * 2, total = (T / 16) * 4;
    for (int pass = 0; pass < 2; ++pass)
    for (int item = pass == 0 ? ((int)blockIdx.x >= nbig && nsmall ? ((int)blockIdx.x - nbig) * 8 + wid : total) : nx + (int)blockIdx.x * 8 + wid; item < (pass == 0 ? nx : total); item += (pass == 0 ? nsmall : G) * 8) {
        const int rb = item >> 2, g = item & 3;
        if (g == 0) pool_block<2, 16>(P, XB, DB, l, rb * 16, g, lane);
        else if (g == 1) pool_block<4, 16>(P, XB, DB, l, rb * 16, g, lane);
        else if (g == 2) pool_block<8, 16>(P, XB, DB, l, rb * 16, g, lane);
        else {
#pragma nounroll
            for (int hb = 0; hb < 2; ++hb) pool_block<16, 8>(P, XB, DB, l, rb * 16 + hb * 8, g, lane); }
    }
}
__device__ void fixup_phase(const Params& P, LAS unsigned char* lds, int l, int first, int stride, int end) {
    const int tid = otid(), cgq = tid & 31, rr = tid >> 5; unsigned char* ws = ows(P.ws);
    bf16_t* PB = (bf16_t*)(ws + WS_BUF + 1 * BUF_BYTES); const bf16_t* QB = (const bf16_t*)(ws + WS_BUF + 2 * BUF_BYTES);
    const f32x2* AGG = (const f32x2*)(ws + WS_AGG);
    LAS float* cs = (LAS float*)lds;
    for (int item = first; item < end; item += stride) {
        const int pm = item >> 3, cb = item & 7;
        const bool smp = pm >= 128;
        __syncthreads();
        if (tid < 256) {
            const int ch = cb * 256 + tid;
            if (!smp) { const int st = pm >> 6, tl = pm & 63; float c = 0.f; const f32x2* ap = AGG + (size_t)(st * 64) * D + ch;
                int j = 0;
                for (; j + 8 <= tl; j += 8) { f32x2 q[8];
#pragma unroll
                    for (int k = 0; k < 8; ++k) q[k] = ap[(size_t)(j + k) * D];
#pragma unroll
                    for (int k = 0; k < 8; ++k) c = q[k][0] * c + q[k][1]; }
                for (; j < tl; ++j) { const f32x2 q = ap[(size_t)j * D]; c = q[0] * c + q[1]; }
                cs[tid] = c; cs[256 + tid] = c; cs[512 + tid] = c; cs[768 + tid] = c;
                if (tl == 63) { const f32x2 q = ap[(size_t)63 * D]; P.out[O_LP + (size_t)(l * 2 + st) * D + ch] = q[0] * c + q[1]; }
            } else {
#pragma unroll
                for (int q4 = 0; q4 < 4; ++q4) { const int s = (pm - 128) * 4 + q4; const float h0 = P.in[5][(size_t)(l * 32 + s) * D + ch]; const f32x2 q = AGG[(size_t)(128 + s) * D + ch];
                    cs[q4 * 256 + tid] = h0; P.out[O_LS + (size_t)(l * 32 + s) * D + ch] = q[0] * h0 + q[1]; }
            }
        }
        __syncthreads();
        const int ch0 = cb * 256 + cgq * 8;
#pragma unroll
        for (int half = 0; half < 2; ++half) {
            u32x4 pv[8], qv[8];
#pragma unroll
            for (int k = 0; k < 8; ++k) { const size_t off = (size_t)(pm * 256 + (half * 8 + k) * 16 + rr) * D + ch0; pv[k] = *(const u32x4*)(PB + off); qv[k] = *(const u32x4*)(QB + off); }
#pragma unroll
            for (int k = 0; k < 8; ++k) { const int seg = (half * 8 + k) >> 2; const size_t off = (size_t)(pm * 256 + (half * 8 + k) * 16 + rr) * D + ch0;
                const f32x4 c0 = *(const LAS f32x4*)(cs + seg * 256 + cgq * 8), c1 = *(const LAS f32x4*)(cs + seg * 256 + cgq * 8 + 4);
                const F8 p = unpack8(pv[k]), q = unpack8(qv[k]); F8 y;
#pragma unroll
                for (int i = 0; i < 4; ++i) { y.v[i] = p.v[i] + q.v[i] * c0[i]; y.v[4 + i] = p.v[4 + i] + q.v[4 + i] * c1[i]; }
                *(u32x4*)(PB + off) = pack8(y); }
        }
    }
    __syncthreads();
}


#define XB_TMO      128
#define XB_XCNT(j)  (256  + 64 * (j))
#define XB_XSUB(j)  (1280 + 64 * (j))
#define XB_XGEN(j)  (2304 + 64 * (j))
#define XB_TOP      3328
#define XB_TOPGEN   3392
#define XCD_BAR_WORDS 3456
#define XB_SPIN_CAP (1u << 22)
constexpr size_t WS_BAR = (size_t)7 << 20;
__device__ __forceinline__ unsigned xb_ld(unsigned* p)              { return __hip_atomic_load(p, __ATOMIC_RELAXED, __HIP_MEMORY_SCOPE_AGENT); }
__device__ __forceinline__ unsigned xb_add(unsigned* p, unsigned v) { return __hip_atomic_fetch_add(p, v, __ATOMIC_RELAXED, __HIP_MEMORY_SCOPE_AGENT); }
__device__ __forceinline__ unsigned xb_xcc_id() { return (unsigned)__builtin_amdgcn_s_getreg((3 << 11) | 20) & 0xFu; }
#define XB_SPIN(cond, bar) do { unsigned _sp = 0; while (cond) { __builtin_amdgcn_s_sleep(1); \
    if ((++_sp & 255u) == 0u) { if (xb_ld(&(bar)[XB_TMO])) break; if (_sp > XB_SPIN_CAP) { atomicAdd(&(bar)[XB_TMO], 1u); break; } } } } while (0)
struct XcdBarrier { unsigned* bar; unsigned x; volatile LAS unsigned* st; };
__device__ __forceinline__ XcdBarrier xcd_barrier_post(unsigned* bar, volatile LAS unsigned* st) {
    XcdBarrier b; b.bar = bar; b.x = xb_xcc_id(); b.st = st;
    if (threadIdx.x == 0) (void)xb_add(&bar[XB_XCNT(b.x)], 1u);
    return b;
}
__device__ __forceinline__ void xcd_barrier_complete(unsigned* bar, unsigned x, unsigned& nloc, unsigned& nx) {
    const unsigned G = gridDim.x * gridDim.y * gridDim.z;
    unsigned sum, cnt, mine, sp = 0u;
    for (;;) {
        sum = 0u; cnt = 0u; mine = 0u;
#pragma unroll
        for (unsigned j = 0; j < 16; ++j) { const unsigned c = xb_ld(&bar[XB_XCNT(j)]); sum += c; cnt += (c > 0u) ? 1u : 0u; mine = (j == x) ? c : mine; }
        if (sum == G) break;
        __builtin_amdgcn_s_sleep(1);
        if ((++sp & 255u) == 0u) { if (xb_ld(&bar[XB_TMO])) break; if (sp > XB_SPIN_CAP) { atomicAdd(&bar[XB_TMO], 1u); break; } }
    }
    nloc = mine > 0u ? mine : 1u; nx = cnt > 0u ? cnt : 1u;
}
__device__ __forceinline__ void xcd_barrier(const XcdBarrier& b) {
    asm volatile("s_waitcnt vmcnt(0)" ::: "memory");
    __syncthreads();
    if (threadIdx.x == 0) {
        unsigned* bar = b.bar;
        __builtin_amdgcn_s_waitcnt(0);
        unsigned nloc = b.st[0], nx = b.st[1];
        if (nloc == 0u) { xcd_barrier_complete(bar, b.x, nloc, nx); b.st[0] = nloc; b.st[1] = nx; }
        const unsigned old = xb_add(&bar[XB_XSUB(b.x)], 1u);
        const unsigned gen = old / nloc;
        if (old + 1u == (gen + 1u) * nloc) {
            __builtin_amdgcn_fence(__ATOMIC_RELEASE, "agent");
            asm volatile("s_waitcnt vmcnt(0)" ::: "memory");
            const unsigned og = xb_add(&bar[XB_TOP], 1u);
            const unsigned tg = og / nx;
            if (og + 1u == (tg + 1u) * nx) xb_add(&bar[XB_TOPGEN], 1u);
            else XB_SPIN(xb_ld(&bar[XB_TOPGEN]) == tg, bar);
            __builtin_amdgcn_fence(__ATOMIC_ACQUIRE, "agent");
            xb_add(&bar[XB_XGEN(b.x)], 1u);
            asm volatile("s_waitcnt vmcnt(0)" ::: "memory");
        } else {
            XB_SPIN(xb_ld(&bar[XB_XGEN(b.x)]) == gen, bar);
            __builtin_amdgcn_fence(__ATOMIC_ACQUIRE, "agent");
            asm volatile("s_waitcnt vmcnt(0)" ::: "memory");
        }
    }
    __syncthreads();
}

__global__ void __launch_bounds__(512, 2) fwd_kernel(Params P) {
    extern __shared__ __attribute__((aligned(16))) unsigned char shm[];
    LAS unsigned char* lds = (LAS unsigned char*)shm;
    cg::grid_group grid = cg::this_grid();
    const int lo = P.ph_lo, hi = P.ph_hi;
    const int G = gridDim.x, bx = blockIdx.x;
    volatile LAS unsigned* bst = (volatile LAS unsigned*)(lds + LDS_BYTES - 16);
    if (threadIdx.x < 4) bst[threadIdx.x] = 0u;
    __syncthreads();
    XcdBarrier xbar; xbar.bar = (unsigned*)(P.ws + WS_BAR); xbar.x = 0; xbar.st = bst;
    if (P.coop) xbar = xcd_barrier_post((unsigned*)(P.ws + WS_BAR), bst);
    if (P.pad == 0x7fffffff) grid.sync();
#define PHASE_PTRS unsigned char* ws = ows(P.ws); bf16_t* H = (bf16_t*)(ws + WS_BUF); bf16_t* B0 = H + BUF_ELEMS; bf16_t* B1 = B0 + BUF_ELEMS; bf16_t* B2 = B1 + BUF_ELEMS; bf16_t* B3 = B2 + BUF_ELEMS; bf16_t* B4 = B3 + BUF_ELEMS; \
    (void)H; (void)B0; (void)B1; (void)B2; (void)B3; (void)B4
#pragma nounroll
    for (int ph = lo; ph < hi; ++ph) {
        if (ph == 0) { mod_phase(P, lds); transpose_phase(P, lds); }
        else if (ph == 15) norm_phase(P, 0, true);
        else {
            const int l = (ph - 1) / 7, s = (ph - 1) % 7;
            if (s == 0) norm_phase(P, l, false);
            else if (s == 1 || s == 4) {
                PHASE_PTRS; const bf16_t* WinT = (const bf16_t*)(ws + WS_WIN) + l * WIN_L;
                const bool first = s == 1;
                pg8::Gemm g{H, first ? WinT : WinT + (size_t)8192 * D, nullptr}; pg8::StaticOrder S; S.init(T, first ? 8192 : 4096, G, bx);
                EpiAct E{first ? B0 : B2, first ? (long)BUF_ELEMS : 2 * (long)BUF_ELEMS, first ? 0 : 2, first ? 1 : 2, first ? (bf16_t*)(ws + WS_HALO) : (bf16_t*)nullptr};
                pg8::gemm_phase<EpiAct, D, D, D, 0, 0>(lds, g, S, E);
                if (!first) {
                    const int nidle = G - (2176 % G);
                    if (2176 % G != 0 && bx >= G - nidle) fixup_phase(P, lds, l, (NT * 8) / 2 + (bx - (G - nidle)), nidle, NT * 8);
                    else if (2176 % G == 0) fixup_phase(P, lds, l, (NT * 8) / 2 + bx, G, NT * 8);
                }
            } else if (s == 2) {
                { int par = 0; for (int item = bx; item < NT * 16; item += G, par ^= 1) a_unit(P, lds, l, item >> 4, item & 15, par); }
                pool_pass(P, l);
            } else if (s == 3) {
                { PHASE_PTRS; const bf16_t* PoolT = (const bf16_t*)(ws + WS_POOL) + l * POOL_L;
                  pg8::Gemm g{B4, PoolT, nullptr}; pg8::StaticOrder S; S.init(T, D, G, bx);
                  EpiPool E{B3, P.in[19] + (size_t)l * D};
                  pg8::gemm_phase<EpiPool, 512, D, 512, 1, 512>(lds, g, S, E); }
                fixup_phase(P, lds, l, bx, G, (NT * 8) / 2);
            } else if (s == 5) {
                PHASE_PTRS; const bf16_t* WcatT = (const bf16_t*)(ws + WS_WCAT) + l * WCAT_L;
                pg8::Gemm g{B0, WcatT, B3}; pg8::StaticOrder S; S.init(T, D, G, bx); EpiGate2 E{B2, B4, H};
                pg8::gemm_phase<EpiGate2, 4096, D, 4096, 0, 0, 2>(lds, g, S, E);
            } else {
                PHASE_PTRS; const bf16_t* WoT = (const bf16_t*)(ws + WS_WO) + l * WO_L; const float* MODl = (const float*)(ws + WS_MOD) + (size_t)l * 34 * 6144;
                pg8::Gemm g{H, WoT, nullptr}; pg8::StaticOrder S; S.init(T, D, G, bx);
                EpiRes E{l == 0 ? P.in[0] : P.out, l == 0 ? P.in[1] : P.out + (size_t)TP * D, P.out, MODl};
                pg8::gemm_phase<EpiRes, D, D, D, 0, 0>(lds, g, S, E);
            }
        }
        if (P.coop && ph + 1 < hi) xcd_barrier(xbar);
    }

}

extern "C" void kernel_launch(void* const* d_in, const int* in_sizes, int n_in, void* d_out, int out_size, void* d_ws, size_t ws_size, hipStream_t stream) {
    static int grid = 0;
    if (grid == 0) {
        int dev = 0, cus = 0, per_cu = 0;
        hipGetDevice(&dev);
        hipDeviceGetAttribute(&cus, hipDeviceAttributeMultiprocessorCount, dev);
        if (hipFuncSetAttribute((const void*)fwd_kernel, hipFuncAttributeMaxDynamicSharedMemorySize, LDS_BYTES) != hipSuccess) fprintf(stderr, "kernel_launch: hipFuncSetAttribute failed\n");
        if (hipOccupancyMaxActiveBlocksPerMultiprocessor(&per_cu, (const void*)fwd_kernel, 512, LDS_BYTES) != hipSuccess || per_cu < 1) { fprintf(stderr, "kernel_launch: occupancy query says %d\n", per_cu); per_cu = 1; }
        (void)hipGetLastError();
        grid = cus * 1;
        if (n_in != 24 || ws_size < WS_BUF + 6 * BUF_BYTES) fprintf(stderr, "kernel_launch: unexpected n_in %d / ws_size %zu\n", n_in, ws_size);
    }
    Params p{};
    for (int i = 0; i < 24; ++i) p.in[i] = (const float*)d_in[i];
    p.out = (float*)d_out; p.ws = (unsigned char*)d_ws;
#if N_LAUNCH_MODE == 1
    p.ph_lo = 0; p.ph_hi = NPH; p.coop = 1; p.pad = 0;
    if (hipMemsetAsync((char*)d_ws + WS_BAR, 0, XCD_BAR_WORDS * 4, stream) != hipSuccess) fprintf(stderr, "kernel_launch: memset of barrier words failed\n");
    void* args[] = {&p};
    hipError_t e = hipLaunchCooperativeKernel((const void*)fwd_kernel, dim3(grid), dim3(512), args, LDS_BYTES, stream);
    if (e != hipSuccess) fprintf(stderr, "cooperative launch failed: %s (grid %d)\n", hipGetErrorString(e), grid);
#else
    for (int k = 0; k < NPH; ++k) { p.ph_lo = k; p.ph_hi = k + 1; p.coop = 0; p.pad = 0; hipLaunchKernelGGL(fwd_kernel, dim3(grid), dim3(512), LDS_BYTES, stream, p); }
#endif
}
```

```cpp
#include <hip/hip_runtime.h>
#include <hip/hip_cooperative_groups.h>
#include <cstdio>
#include <cstdint>
namespace cg = cooperative_groups;

#define LAS __attribute__((address_space(3)))
typedef unsigned short bf16_t;
typedef unsigned int u32;
typedef short bf16x8 __attribute__((ext_vector_type(8)));
typedef float f32x4 __attribute__((ext_vector_type(4)));
typedef float f32x2 __attribute__((ext_vector_type(2)));
typedef unsigned u32x4 __attribute__((ext_vector_type(4)));
typedef unsigned u32x2 __attribute__((ext_vector_type(2)));

#ifndef N_LAUNCH_MODE
#define N_LAUNCH_MODE 1
#endif

constexpr int D = 2048, T = 34816, TP = 32768, NSTREAM = 34, DIN = 12288, NT = T / 256  ;
constexpr float EPS = 1e-6f;
constexpr size_t O_YP = 0, O_YS = 67108864, O_CP = 71303168, O_LP = 71327744, O_PP = 71335936, O_CS = 71458816, O_LS = 71852032, O_PS = 71983104;
constexpr size_t BUF_ELEMS = (size_t)T * D, BUF_BYTES = BUF_ELEMS * 2;
constexpr size_t WS_MOD = 4096, WS_AGG = (size_t)2 << 20, WS_HALO = (size_t)5 << 20, WS_WIN = (size_t)8 << 20;
constexpr size_t WIN_L = (size_t)DIN * D  , WCAT_L = (size_t)D * 4096, WO_L = (size_t)D * D, GT_L = (size_t)16 * 2 * 128 * 128, POOL_L = (size_t)D * 512;
constexpr size_t WS_WCAT = WS_WIN + 2 * WIN_L * 2, WS_WO = WS_WCAT + 2 * WCAT_L * 2, WS_GT = WS_WO + 2 * WO_L * 2, WS_POOL = WS_GT + 2 * GT_L * 2, WS_BUF = (size_t)160 << 20;
static_assert(WS_POOL + 2 * POOL_L * 2 <= WS_BUF, "weights overflow");
constexpr int LDS_BYTES = 136 * 1024;
constexpr int NPH = 16;

struct Params { const float* in[24]; float* out; unsigned char* ws; int ph_lo, ph_hi, coop, pad; };

__device__ __forceinline__ u32 pk_bf16(float lo, float hi) { u32 r; asm volatile("v_cvt_pk_bf16_f32 %0, %1, %2" : "=v"(r) : "v"(lo), "v"(hi)); return r; }
__device__ __forceinline__ float bflo(u32 u) { return __uint_as_float(u << 16); }
__device__ __forceinline__ float bfhi(u32 u) { return __uint_as_float(u & 0xffff0000u); }
__device__ __forceinline__ float sigm(float x) { return __builtin_amdgcn_rcpf(1.0f + __expf(-x)); }
__device__ __forceinline__ int stream_of_row(int row) { return row < TP ? (row >> 14) : 2 + ((row - TP) >> 6); }
__device__ __forceinline__ int otid() { int t = threadIdx.x; asm volatile("" : "+v"(t)); return t; }
__device__ __forceinline__ unsigned char* ows(unsigned char* p) { asm volatile("" : "+s"(p)); return p; }
struct F8 { float v[8]; };
__device__ __forceinline__ F8 unpack8(u32x4 w) { F8 r; r.v[0] = bflo(w.x); r.v[1] = bfhi(w.x); r.v[2] = bflo(w.y); r.v[3] = bfhi(w.y); r.v[4] = bflo(w.z); r.v[5] = bfhi(w.z); r.v[6] = bflo(w.w); r.v[7] = bfhi(w.w); return r; }
__device__ __forceinline__ u32x4 pack8(const F8& f) { u32x4 w; w.x = pk_bf16(f.v[0], f.v[1]); w.y = pk_bf16(f.v[2], f.v[3]); w.z = pk_bf16(f.v[4], f.v[5]); w.w = pk_bf16(f.v[6], f.v[7]); return w; }
__device__ __forceinline__ F8 ldf8(const float* p) { const f32x4 a = *(const f32x4*)p, b = *(const f32x4*)(p + 4); F8 r; r.v[0] = a[0]; r.v[1] = a[1]; r.v[2] = a[2]; r.v[3] = a[3]; r.v[4] = b[0]; r.v[5] = b[1]; r.v[6] = b[2]; r.v[7] = b[3]; return r; }
__device__ __forceinline__ void stf8(float* p, const F8& f) { *(f32x4*)p = (f32x4){f.v[0], f.v[1], f.v[2], f.v[3]}; *(f32x4*)(p + 4) = (f32x4){f.v[4], f.v[5], f.v[6], f.v[7]}; }

namespace pg8 {
constexpr int BM = 256, BK = 64, HALF = 128, HTB = HALF * BK * 2, STAGE_BYTES = 8 * HTB, NXCD = 8, WGM = 4;
__device__ __forceinline__ int lds_byte(int r, int c) { const int st = (r >> 4) * 2 + (c >> 5), rr = r & 15, cc = c & 31, ob = rr * 64 + cc * 2; return st * 1024 + (ob ^ (((ob >> 9) & 1) << 5)); }
__device__ __forceinline__ void stage_rc(int b, int& R, int& C) { const int st = b / 1024, sb = b % 1024, swz = sb ^ (((sb >> 9) & 1) << 5); R = (st >> 1) * 16 + swz / 64; C = (st & 1) * 32 + (swz % 64) / 2; }
__device__ __forceinline__ int perm32(int rho) { const int n = rho >> 4, i = rho & 15; return 8 * (i >> 2) + 4 * n + (i & 3); }
struct Unit { int pm, pn, r0, c0, mask; };
struct Gemm { const bf16_t* A; const bf16_t* Bt; const bf16_t* A2; };
struct StaticOrder {
    int nM, nN, nwg, G, c;
    __device__ void init(int M, int N, int G_, int c_) { nM = M / BM; nN = N / BM; nwg = nM * nN; G = G_; c = c_; }
    __device__ void locate(int L, Unit& u) const {
        int wgid = L; { const int q = nwg / NXCD, r = nwg % NXCD, xcd = wgid % NXCD, off = wgid / NXCD; wgid = (xcd < r ? xcd * (q + 1) : r * (q + 1) + (xcd - r) * q) + off; }
        const int nig = WGM * nN, gid = wgid / nig, fm = gid * WGM, gsz = (nM - fm) < WGM ? (nM - fm) : WGM;
        u.pm = fm + ((wgid % nig) % gsz); u.pn = (wgid % nig) / gsz; u.r0 = u.pm * BM; u.c0 = u.pn * BM; u.mask = 0xF;
    }
    __device__ bool quarter_tail() const { const int rem = nwg % G; return rem > 0 && rem * 4 <= G; }
    __device__ bool next(int i, Unit& u) const { const long L = (long)i * G + c; if (quarter_tail() ? i >= nwg / G : L >= nwg) return false; locate((int)L, u); return true; }
    __device__ int n_tail() const { return (quarter_tail() && (nwg % G) * 4 > c) ? 1 : 0; }
    __device__ void tail(int k, Unit& u) const { const int q = c + k * G; locate((nwg / G) * G + (q >> 2), u); u.r0 += ((q >> 1) & 1) * HALF; u.c0 += (q & 1) * HALF; u.mask = 1; }
};
template <class Epi, int K, int LDA, int LDB, int APN_SHIFT, int APN_ELEMS, int KSEG>
__device__ __forceinline__ void gemm_tail(LAS unsigned char* lds, const Gemm g, const Epi& E, const Unit u) {
    const int tid = otid(), wid = __builtin_amdgcn_readfirstlane(tid >> 6), lane = tid & 63, wr = wid >> 2, wc = wid & 3, fr = lane & 15, fq = lane >> 4;
    constexpr int nt = K / BK, nts = nt / KSEG;
    unsigned voffA[2], voffB[2];
#pragma unroll
    for (int i = 0; i < 2; ++i) { int R, C; stage_rc(tid * 16 + i * 8192, R, C); const int Rb = Epi::PERM ? ((R & ~31) + perm32(R & 31)) : R;
        voffA[i] = (unsigned)(R * LDA + C) * 2u; voffB[i] = (unsigned)(Rb * LDB + C) * 2u; }
    constexpr size_t kstep = (size_t)(BK * 2);
    const unsigned ldsw = (unsigned)wid * 1024u;
    const int aoff = lds_byte(wr * 64 + fr, fq * 8), boff = lds_byte(wc * 32 + fr, fq * 8);
    const char* gA = (const char*)g.A + ((size_t)u.r0 * LDA + (size_t)((u.pn >> APN_SHIFT) * APN_ELEMS)) * 2;
    const char* gA2 = KSEG == 2 ? (const char*)g.A2 + (size_t)u.r0 * LDA * 2 : gA;
    const char* gB = (const char*)g.Bt + (size_t)u.c0 * LDB * 2;
#define TL_STAGE(bufoff, gbase, voff) do { _Pragma("unroll") for (int _i = 0; _i < 2; ++_i) \
        __builtin_amdgcn_global_load_lds((const unsigned*)((const char*)(gbase) + (voff)[_i]), (LAS unsigned*)(lds + (bufoff) + ldsw + _i * 8192), 16, 0, 0); } while (0)
#define TL_LOAD(tt) do { const int _s = (tt) & 3; const char* _a = (KSEG == 2 && (tt) >= nts) ? gA2 + (size_t)((tt) - nts) * kstep : gA + (size_t)(tt) * kstep; \
        TL_STAGE((2 * _s) * HTB, _a, voffA); TL_STAGE((2 * _s + 1) * HTB, gB + (size_t)(tt) * kstep, voffB); } while (0)
    f32x4 acc[2][2][4][2];
#pragma unroll
    for (int a = 0; a < 2; ++a)
#pragma unroll
        for (int b = 0; b < 2; ++b)
#pragma unroll
            for (int m = 0; m < 4; ++m)
#pragma unroll
                for (int n = 0; n < 2; ++n) acc[a][b][m][n] = (f32x4){0.f, 0.f, 0.f, 0.f};
    TL_LOAD(0); TL_LOAD(1); TL_LOAD(2);
#pragma nounroll
    for (int t = 0; t < nt; ++t) {
        if constexpr (KSEG == 2) { if (t == nts) E.mid(acc, u, wr, wc, fr, fq); }
        const int rem = nt - t;
        if (rem >= 3) asm volatile("s_waitcnt vmcnt(8)" ::: "memory"); else if (rem == 2) asm volatile("s_waitcnt vmcnt(4)" ::: "memory"); else asm volatile("s_waitcnt vmcnt(0)" ::: "memory");
        __builtin_amdgcn_s_barrier();
        asm volatile("" ::: "memory");
        if (t + 3 < nt) TL_LOAD(t + 3);
        const int s = t & 3;
        bf16x8 At[4][2], Bf[2][2];
#pragma unroll
        for (int m = 0; m < 4; ++m)
#pragma unroll
            for (int k = 0; k < 2; ++k) At[m][k] = *(const LAS bf16x8*)(lds + (2 * s) * HTB + aoff + m * 2048 + k * 1024);
#pragma unroll
        for (int n = 0; n < 2; ++n)
#pragma unroll
            for (int k = 0; k < 2; ++k) Bf[n][k] = *(const LAS bf16x8*)(lds + (2 * s + 1) * HTB + boff + n * 2048 + k * 1024);
        asm volatile("s_waitcnt lgkmcnt(0)" ::: "memory");
#pragma unroll
        for (int m = 0; m < 4; ++m)
#pragma unroll
            for (int n = 0; n < 2; ++n)
#pragma unroll
                for (int k = 0; k < 2; ++k) acc[0][0][m][n] = __builtin_amdgcn_mfma_f32_16x16x32_bf16(Bf[n][k], At[m][k], acc[0][0][m][n], 0, 0, 0);
    }
    E(acc, u, wr, wc, fr, fq);
    asm volatile("s_waitcnt vmcnt(0)" ::: "memory");
    __builtin_amdgcn_s_barrier();
#undef TL_STAGE
#undef TL_LOAD
}
template <class Epi, int K, int LDA, int LDB, int APN_SHIFT, int APN_ELEMS, int KSEG = 1>
__device__ __forceinline__ void gemm_phase(LAS unsigned char* lds, const Gemm g, const StaticOrder& S, const Epi& E) {
    const int tid = otid(), wid = __builtin_amdgcn_readfirstlane(tid >> 6), lane = tid & 63, wr = wid >> 2, wc = wid & 3, fr = lane & 15, fq = lane >> 4;
    constexpr int nt = K / BK, nts = nt / KSEG;
    unsigned voffA[2], voffB[2];
#pragma unroll
    for (int i = 0; i < 2; ++i) { int R, C; stage_rc(tid * 16 + i * 8192, R, C); const int Rb = Epi::PERM ? ((R & ~31) + perm32(R & 31)) : R;
        voffA[i] = (unsigned)(R * LDA + C) * 2u; voffB[i] = (unsigned)(Rb * LDB + C) * 2u; }
    constexpr size_t kstep = (size_t)(BK * 2);
    constexpr size_t hstepA = (size_t)HALF * LDA * 2, hstepB = (size_t)HALF * LDB * 2;
    constexpr size_t tstepA = 2 * hstepA, tstepB = 2 * hstepB;
    const unsigned ldsw = (unsigned)wid * 1024u;
    const int aoff = lds_byte(wr * 64 + fr, fq * 8), boff = lds_byte(wc * 32 + fr, fq * 8);
#define PG8_SA(b, h) (((b) * 2 + (h)) * HTB)
#define PG8_SB(b, h) ((4 + (b) * 2 + (h)) * HTB)
#define PG8_STAGE(bufoff, gbase, voff) do { _Pragma("unroll") for (int _i = 0; _i < 2; ++_i) \
        __builtin_amdgcn_global_load_lds((const unsigned*)((const char*)(gbase) + (voff)[_i]), (LAS unsigned*)(lds + (bufoff) + ldsw + _i * 8192), 16, 0, 0); } while (0)
#define PG8_LDA(dst, b, h) do { _Pragma("unroll") for (int m = 0; m < 4; ++m) _Pragma("unroll") for (int k = 0; k < 2; ++k) dst[m][k] = *(const LAS bf16x8*)(lds + PG8_SA(b, h) + aoff + m * 2048 + k * 1024); } while (0)
#define PG8_LDB(dst, b, h) do { _Pragma("unroll") for (int n = 0; n < 2; ++n) _Pragma("unroll") for (int k = 0; k < 2; ++k) dst[n][k] = *(const LAS bf16x8*)(lds + PG8_SB(b, h) + boff + n * 2048 + k * 1024); } while (0)
#define PG8_MMA(ai, bj, At, Bt) do { __builtin_amdgcn_s_setprio(1); _Pragma("unroll") for (int m = 0; m < 4; ++m) _Pragma("unroll") for (int n = 0; n < 2; ++n) _Pragma("unroll") for (int k = 0; k < 2; ++k) \
        acc[ai][bj][m][n] = __builtin_amdgcn_mfma_f32_16x16x32_bf16(Bt[n][k], At[m][k], acc[ai][bj][m][n], 0, 0, 0); __builtin_amdgcn_s_setprio(0); } while (0)
#define PG8_WAIT_V(n) asm volatile("s_waitcnt vmcnt(" #n ")" ::: "memory")
#define PG8_WAIT_L(n) asm volatile("s_waitcnt lgkmcnt(" #n ")" ::: "memory")
#define PG8_BAR __builtin_amdgcn_s_barrier()
#define PG8_SCHED __builtin_amdgcn_sched_barrier(0)
    Unit cur, nxt; int ui = 0;
    if (!S.next(0, cur)) return;
    f32x4 acc[2][2][4][2];
#pragma unroll
    for (int a = 0; a < 2; ++a)
#pragma unroll
        for (int b = 0; b < 2; ++b)
#pragma unroll
            for (int m = 0; m < 4; ++m)
#pragma unroll
                for (int n = 0; n < 2; ++n) acc[a][b][m][n] = (f32x4){0.f, 0.f, 0.f, 0.f};
    bf16x8 At[4][2], B0[2][2], B1[2][2];
    const char* cA = (const char*)g.A + (size_t)cur.pm * tstepA + (size_t)((cur.pn >> APN_SHIFT) * APN_ELEMS) * 2; const char* cB = (const char*)g.Bt + (size_t)cur.pn * tstepB;
    const char* cA2 = KSEG == 2 ? (const char*)g.A2 + (size_t)cur.pm * tstepA : cA;
    PG8_STAGE(PG8_SB(0, 0), cB, voffB); PG8_STAGE(PG8_SB(0, 1), cB + hstepB, voffB); PG8_STAGE(PG8_SA(0, 0), cA, voffA); PG8_STAGE(PG8_SA(0, 1), cA + hstepA, voffA);
    if (wr == 1) PG8_BAR;
    PG8_WAIT_V(2); PG8_BAR;
    PG8_STAGE(PG8_SB(1, 0), cB + kstep, voffB); PG8_STAGE(PG8_SA(1, 0), cA + kstep, voffA); PG8_STAGE(PG8_SB(1, 1), cB + hstepB + kstep, voffB);
    PG8_WAIT_V(6); PG8_BAR;
    for (;;) {
        const bool has_next = S.next(ui + 1, nxt);
        const char* nA = has_next ? (const char*)g.A + (size_t)nxt.pm * tstepA + (size_t)((nxt.pn >> APN_SHIFT) * APN_ELEMS) * 2 : cA; const char* nB = has_next ? (const char*)g.Bt + (size_t)nxt.pn * tstepB : cB;
        for (int t = 0; t < nt; t += 2) {
            const bool last = (t == nt - 2);
            const char* a1 = (KSEG == 2 && t >= nts) ? cA2 + (size_t)(t + 1 - nts) * kstep : cA + (size_t)(t + 1) * kstep;
            const char* a2 = last ? nA : ((KSEG == 2 && t + 2 >= nts) ? cA2 + (size_t)(t + 2 - nts) * kstep : cA + (size_t)(t + 2) * kstep); const char* b2 = last ? nB : cB + (size_t)(t + 2) * kstep;
            const char* a3 = a2 + kstep; const char* b3 = b2 + kstep;
            if constexpr (KSEG == 2) { if (t == nts) E.mid(acc, cur, wr, wc, fr, fq); }
            PG8_LDB(B0, 0, 0); PG8_LDB(B1, 0, 1); PG8_SCHED; PG8_LDA(At, 0, 0); PG8_STAGE(PG8_SA(1, 1), a1 + hstepA, voffA);
            PG8_WAIT_V(8); PG8_WAIT_L(0); PG8_BAR; PG8_MMA(0, 0, At, B0); PG8_MMA(0, 1, At, B1); PG8_BAR; PG8_SCHED;
            PG8_LDA(At, 0, 1); PG8_STAGE(PG8_SB(0, 0), b2, voffB); PG8_STAGE(PG8_SB(0, 1), b2 + hstepB, voffB); PG8_STAGE(PG8_SA(0, 0), a2, voffA);
            PG8_WAIT_V(8); PG8_WAIT_L(0); PG8_BAR; PG8_MMA(1, 0, At, B0); PG8_MMA(1, 1, At, B1); PG8_BAR; PG8_SCHED;
            PG8_LDB(B0, 1, 0); PG8_LDB(B1, 1, 1); PG8_SCHED; PG8_LDA(At, 1, 0); PG8_STAGE(PG8_SA(0, 1), a2 + hstepA, voffA);
            PG8_WAIT_V(8); PG8_WAIT_L(0); PG8_BAR; PG8_MMA(0, 0, At, B0); PG8_MMA(0, 1, At, B1); PG8_BAR; PG8_SCHED;
            PG8_LDA(At, 1, 1); PG8_STAGE(PG8_SB(1, 0), b3, voffB); PG8_STAGE(PG8_SB(1, 1), b3 + hstepB, voffB); PG8_STAGE(PG8_SA(1, 0), a3, voffA);
            PG8_WAIT_V(8); PG8_WAIT_L(0); PG8_BAR; PG8_MMA(1, 0, At, B0); PG8_MMA(1, 1, At, B1); PG8_BAR; PG8_SCHED;
        }
        if (wr == 0) PG8_BAR;
        E(acc, cur, wr, wc, fr, fq);
        if (!has_next) break;
#pragma unroll
        for (int a = 0; a < 2; ++a)
#pragma unroll
            for (int b = 0; b < 2; ++b)
#pragma unroll
                for (int m = 0; m < 4; ++m)
#pragma unroll
                    for (int n = 0; n < 2; ++n) acc[a][b][m][n] = (f32x4){0.f, 0.f, 0.f, 0.f};
        cur = nxt; cA = nA; cB = nB; ++ui;
        if constexpr (KSEG == 2) cA2 = (const char*)g.A2 + (size_t)cur.pm * tstepA;
        if (wr == 1) PG8_BAR;
    }
    PG8_WAIT_V(0);
    PG8_BAR;
    for (int k = 0; k < S.n_tail(); ++k) { Unit tu; S.tail(k, tu); gemm_tail<Epi, K, LDA, LDB, APN_SHIFT, APN_ELEMS, KSEG>(lds, g, E, tu); }
#undef PG8_SA
#undef PG8_SB
#undef PG8_STAGE
#undef PG8_LDA
#undef PG8_LDB
#undef PG8_MMA
#undef PG8_WAIT_V
#undef PG8_WAIT_L
#undef PG8_BAR
#undef PG8_SCHED
}
}
using pg8::Unit;

struct EpiAct {
    static constexpr bool PERM = true;
    bf16_t* base; long tstride; int act0, act1; bf16_t* halo;
    __device__ __forceinline__ void operator()(const f32x4 (&acc)[2][2][4][2], const Unit& u, int wr, int wc, int fr, int fq) const {
        const int colt = u.c0, t = colt >> 11, lc = colt & 2047, act = (t & 1) ? act1 : act0;
        bf16_t* dst = base + (long)t * tstride;
        const int col0 = lc + wc * 32 + 8 * fq, row0 = u.r0 + wr * 64 + fr;
#pragma unroll
        for (int ai = 0; ai < 2; ++ai)
#pragma unroll
            for (int m = 0; m < 4; ++m) { bf16_t* rowp = dst + (size_t)(row0 + ai * 128 + m * 16) * D + col0;
#pragma unroll
                for (int bj = 0; bj < 2; ++bj) { if (!((u.mask >> (ai * 2 + bj)) & 1)) continue; f32x4 v0 = acc[ai][bj][m][0], v1 = acc[ai][bj][m][1];
                    if (act == 1) {
#pragma unroll
                        for (int j = 0; j < 4; ++j) { v0[j] = v0[j] * sigm(v0[j]); v1[j] = v1[j] * sigm(v1[j]); } }
                    else if (act == 2) {
#pragma unroll
                        for (int j = 0; j < 4; ++j) { v0[j] = sigm(v0[j]); v1[j] = sigm(v1[j]); } }
                    u32x4 w; w.x = pk_bf16(v0[0], v0[1]); w.y = pk_bf16(v0[2], v0[3]); w.z = pk_bf16(v1[0], v1[1]); w.w = pk_bf16(v1[2], v1[3]);
                    *(u32x4*)(rowp + bj * 128) = w;
                    if (halo && t == 0 && ai == 1 && wr == 1 && m == 3 && fr >= 13) *(u32x4*)(halo + (size_t)(u.pm * 3 + fr - 13) * D + col0 + bj * 128) = w;
                } }
    }
};
struct EpiPool {
    static constexpr bool PERM = true;
    bf16_t* gb; const float* scale;
    __device__ __forceinline__ void operator()(const f32x4 (&acc)[2][2][4][2], const Unit& u, int wr, int wc, int fr, int fq) const {
        const int col0 = u.c0 + wc * 32 + 8 * fq, row0 = u.r0 + wr * 64 + fr;
        f32x4 sc[2][2];
#pragma unroll
        for (int bj = 0; bj < 2; ++bj)
#pragma unroll
            for (int n = 0; n < 2; ++n) sc[bj][n] = *(const f32x4*)(scale + col0 + bj * 128 + 4 * n);
#pragma unroll
        for (int ai = 0; ai < 2; ++ai)
#pragma unroll
            for (int m = 0; m < 4; ++m) { bf16_t* rowp = gb + (size_t)(row0 + ai * 128 + m * 16) * D + col0;
#pragma unroll
                for (int bj = 0; bj < 2; ++bj) { if (!((u.mask >> (ai * 2 + bj)) & 1)) continue; const u32x4 gq = *(const u32x4*)(rowp + bj * 128);
                    const f32x4 v0 = acc[ai][bj][m][0] * sc[bj][0], v1 = acc[ai][bj][m][1] * sc[bj][1];
                    u32x4 w; w.x = pk_bf16(v0[0] * bflo(gq.x), v0[1] * bfhi(gq.x)); w.y = pk_bf16(v0[2] * bflo(gq.y), v0[3] * bfhi(gq.y));
                    w.z = pk_bf16(v1[0] * bflo(gq.z), v1[1] * bfhi(gq.z)); w.w = pk_bf16(v1[2] * bflo(gq.w), v1[3] * bfhi(gq.w));
                    *(u32x4*)(rowp + bj * 128) = w; } }
    }
};
struct EpiGate2 {
    static constexpr bool PERM = true;
    const bf16_t* ga; const bf16_t* gb; bf16_t* dst;
    __device__ __forceinline__ void mid(f32x4 (&acc)[2][2][4][2], const Unit& u, int wr, int wc, int fr, int fq) const {
        int frv = fr; asm volatile("" : "+v"(frv));
        const int col0 = u.c0 + wc * 32 + 8 * fq, row0 = u.r0 + wr * 64 + frv;
#pragma unroll
        for (int ai = 0; ai < 2; ++ai) {
            if (!((u.mask >> (ai * 2)) & 3)) continue;
            u32x4 ra[4][2], rb[4][2];
#pragma unroll
            for (int m = 0; m < 4; ++m) { const size_t off = (size_t)(row0 + ai * 128 + m * 16) * D + col0;
#pragma unroll
                for (int bj = 0; bj < 2; ++bj) { if (!((u.mask >> (ai * 2 + bj)) & 1)) continue; ra[m][bj] = *(const u32x4*)(ga + off + bj * 128); rb[m][bj] = *(const u32x4*)(gb + off + bj * 128); } }
#pragma unroll
            for (int m = 0; m < 4; ++m)
#pragma unroll
                for (int bj = 0; bj < 2; ++bj) { if (!((u.mask >> (ai * 2 + bj)) & 1)) continue;
                    const F8 fa = unpack8(ra[m][bj]), fb = unpack8(rb[m][bj]);
#pragma unroll
                    for (int j = 0; j < 4; ++j) { acc[ai][bj][m][0][j] *= fa.v[j] * __builtin_amdgcn_rcpf(fmaxf(fb.v[j], 1e-20f)); acc[ai][bj][m][1][j] *= fa.v[4 + j] * __builtin_amdgcn_rcpf(fmaxf(fb.v[4 + j], 1e-20f)); } }
            asm volatile("" ::: "memory");
        }
    }
    __device__ __forceinline__ void operator()(const f32x4 (&acc)[2][2][4][2], const Unit& u, int wr, int wc, int fr, int fq) const {
        const int col0 = u.c0 + wc * 32 + 8 * fq, row0 = u.r0 + wr * 64 + fr;
#pragma unroll
        for (int ai = 0; ai < 2; ++ai)
#pragma unroll
            for (int m = 0; m < 4; ++m) { const size_t off = (size_t)(row0 + ai * 128 + m * 16) * D + col0;
#pragma unroll
                for (int bj = 0; bj < 2; ++bj) { if (!((u.mask >> (ai * 2 + bj)) & 1)) continue; const F8 fb = unpack8(*(const u32x4*)(gb + off + bj * 128));
                    const f32x4 a0 = acc[ai][bj][m][0], a1 = acc[ai][bj][m][1]; F8 o;
#pragma unroll
                    for (int j = 0; j < 4; ++j) { o.v[j] = a0[j] * fmaxf(fb.v[j], 1e-20f); o.v[4 + j] = a1[j] * fmaxf(fb.v[4 + j], 1e-20f); }
                    *(u32x4*)(dst + off + bj * 128) = pack8(o); } }
    }
};
struct EpiRes {
    static constexpr bool PERM = false;
    const float* xp; const float* xs; float* out; const float* mod;
    __device__ __forceinline__ void operator()(const f32x4 (&acc)[2][2][4][2], const Unit& u, int wr, int wc, int fr, int fq) const {
        const int col0 = u.c0 + wc * 32 + 4 * fq;
#pragma unroll
        for (int ai = 0; ai < 2; ++ai) {
            if (!((u.mask >> (ai * 2)) & 3)) continue;
            const int rb = u.r0 + ai * 128 + wr * 64, st = stream_of_row(rb);
            const float* gp = mod + (size_t)st * 6144 + 4096 + col0;
            f32x4 gv[2][2];
#pragma unroll
            for (int bj = 0; bj < 2; ++bj)
#pragma unroll
                for (int n = 0; n < 2; ++n) gv[bj][n] = *(const f32x4*)(gp + bj * 128 + n * 16);
            const float* xb = rb < TP ? xp + (size_t)rb * D : xs + (size_t)(rb - TP) * D;
            f32x4 xo[4][2][2];
#pragma unroll
            for (int m = 0; m < 4; ++m) { const size_t ro = (size_t)(m * 16 + fr) * D + col0;
#pragma unroll
                for (int bj = 0; bj < 2; ++bj) { if (!((u.mask >> (ai * 2 + bj)) & 1)) continue;
#pragma unroll
                    for (int n = 0; n < 2; ++n) xo[m][bj][n] = *(const f32x4*)(xb + ro + bj * 128 + n * 16); } }
#pragma unroll
            for (int m = 0; m < 4; ++m) { const size_t ro = (size_t)(m * 16 + fr) * D + col0;
#pragma unroll
                for (int bj = 0; bj < 2; ++bj) { if (!((u.mask >> (ai * 2 + bj)) & 1)) continue;
#pragma unroll
                    for (int n = 0; n < 2; ++n) *(f32x4*)(out + (size_t)rb * D + ro + bj * 128 + n * 16) = xo[m][bj][n] + gv[bj][n] * acc[ai][bj][m][n]; } }
        }
    }
};

__device__ void mod_phase(const Params& P, LAS unsigned char* lds) {
    LAS float* sc = (LAS float*)lds;
    LAS float* red = (LAS float*)(lds + 40960);
    const int tid = otid(), wid = tid >> 6, lane = tid & 63;
    float* MOD = (float*)(ows(P.ws) + WS_MOD);
    for (int item = blockIdx.x; item < 192; item += gridDim.x) {
        const int l = item / 96, jb = item % 96;
        const float* W = P.in[8] + (size_t)l * D * 6144 + jb * 64 + lane;
        float acc[36];
#pragma unroll
        for (int s = 0; s < 36; ++s) acc[s] = 0.f;
        for (int kc = 0; kc < 8; ++kc) {
            __syncthreads();
            for (int i = tid; i < 256 * 34; i += 512) { const int k = i & 255, s = i >> 8; const float c = s < 2 ? P.in[2][s * D + kc * 256 + k] : P.in[3][(s - 2) * D + kc * 256 + k]; sc[k * 36 + s] = c * sigm(c); }
            if (tid < 256) { sc[tid * 36 + 34] = 0.f; sc[tid * 36 + 35] = 0.f; }
            __syncthreads();
#pragma unroll
            for (int kk = 0; kk < 32; ++kk) { const int k = wid * 32 + kk; const float w = W[(size_t)(kc * 256 + k) * 6144];
#pragma unroll
                for (int s4 = 0; s4 < 9; ++s4) { const f32x4 c4 = *(const LAS f32x4*)(sc + k * 36 + s4 * 4); acc[s4 * 4] += c4[0] * w; acc[s4 * 4 + 1] += c4[1] * w; acc[s4 * 4 + 2] += c4[2] * w; acc[s4 * 4 + 3] += c4[3] * w; } }
        }
#pragma unroll
        for (int s = 0; s < 34; ++s) red[(wid * 34 + s) * 64 + lane] = acc[s];
        __syncthreads();
        for (int i = tid; i < 34 * 64; i += 512) { float v = 0.f;
#pragma unroll
            for (int w = 0; w < 8; ++w) v += red[w * 34 * 64 + i];
            const int s = i >> 6, j = jb * 64 + (i & 63); MOD[(size_t)(l * 34 + s) * 6144 + j] = v + P.in[9][l * 6144 + j]; }
    }
    __syncthreads();
}
struct TDesc { const float* src; bf16_t* dst; int N, ldd; };
__device__ __forceinline__ TDesc tile_desc(const Params& P, unsigned char* ws, int item) {
    const int l = item / 4800; int r = item % 4800;
    const float* src; bf16_t* dst; int K, N, ldd;
    if (r < 3072) { src = P.in[10] + (size_t)l * D * DIN; dst = (bf16_t*)(ws + WS_WIN) + l * WIN_L; K = D; N = DIN; ldd = D; }
    else if (r < 3584) { r -= 3072; src = P.in[20] + (size_t)l * D * D; dst = (bf16_t*)(ws + WS_WCAT) + l * WCAT_L; K = D; N = D; ldd = 4096; }
    else if (r < 4096) { r -= 3584; src = P.in[21] + (size_t)l * D * D; dst = (bf16_t*)(ws + WS_WCAT) + l * WCAT_L + 2048; K = D; N = D; ldd = 4096; }
    else if (r < 4608) { r -= 4096; src = P.in[22] + (size_t)l * D * D; dst = (bf16_t*)(ws + WS_WO) + l * WO_L; K = D; N = D; ldd = D; }
    else if (r < 4640) { r -= 4608; const int h = r >> 1; r &= 1; src = P.in[13] + (size_t)(l * 16 + h) * 16384; dst = (bf16_t*)(ws + WS_GT) + l * GT_L + (size_t)(h * 2 + 0) * 16384; K = 128; N = 128; ldd = 128; }
    else if (r < 4672) { r -= 4640; const int h = r >> 1; r &= 1; src = P.in[15] + (size_t)(l * 16 + h) * 16384; dst = (bf16_t*)(ws + WS_GT) + l * GT_L + (size_t)(h * 2 + 1) * 16384; K = 128; N = 128; ldd = 128; }
    else { r -= 4672; const int gi = r >> 5; r &= 31; src = P.in[18] + (size_t)(l * 4 + gi) * 262144; dst = (bf16_t*)(ws + WS_POOL) + l * POOL_L + (size_t)gi * 262144; K = 512; N = 512; ldd = 512; }
    (void)K;
    const int ntn = N / 64, nt = r % ntn, kt = r / ntn, k0 = kt * 128, n0 = nt * 64;
    TDesc d; d.src = src + (size_t)k0 * N + n0; d.dst = dst + (size_t)n0 * ldd + k0; d.N = N; d.ldd = ldd; return d;
}
__device__ void transpose_phase(const Params& P, LAS unsigned char* lds) {
    LAS float* tl = (LAS float*)lds;
    const int tid = otid(); unsigned char* ws = ows(P.ws);
    const int G = gridDim.x;
    int item = blockIdx.x;
    f32x4 v[4];
    { const TDesc d = tile_desc(P, ws, item); const float* sp = d.src + (size_t)(tid >> 4) * d.N + (tid & 15) * 4;
#pragma unroll
      for (int p = 0; p < 4; ++p) v[p] = *(const f32x4*)(sp + (size_t)(p * 32) * d.N); }
#pragma nounroll
    for (; item < 9600; item += G) {
#pragma unroll
        for (int p = 0; p < 4; ++p) { const int k = p * 32 + (tid >> 4), n4 = (tid & 15) * 4; tl[k * 65 + n4] = v[p][0]; tl[k * 65 + n4 + 1] = v[p][1]; tl[k * 65 + n4 + 2] = v[p][2]; tl[k * 65 + n4 + 3] = v[p][3]; }
        __syncthreads();
        if (item + G < 9600) { const TDesc d = tile_desc(P, ws, item + G); const float* sp = d.src + (size_t)(tid >> 4) * d.N + (tid & 15) * 4;
#pragma unroll
            for (int p = 0; p < 4; ++p) v[p] = *(const f32x4*)(sp + (size_t)(p * 32) * d.N); }
        { const TDesc c = tile_desc(P, ws, item);
#pragma unroll
          for (int p = 0; p < 2; ++p) { const int n = p * 32 + (tid >> 4), k8 = (tid & 15) * 8; F8 f;
#pragma unroll
            for (int j = 0; j < 8; ++j) f.v[j] = tl[(k8 + j) * 65 + n];
            *(u32x4*)(c.dst + (size_t)n * c.ldd + k8) = pack8(f); } }
        __syncthreads();
    }
}
__device__ void norm_phase(const Params& P, int l, bool final_) {
    const int tid = otid(), wid = tid >> 6, lane = tid & 63; unsigned char* ws = ows(P.ws);
    bf16_t* H = (bf16_t*)(ws + WS_BUF);
    const float* MOD = (const float*)(ws + WS_MOD);
    for (int row = blockIdx.x * 8 + wid; row < T; row += gridDim.x * 8) {
        const float* x = (l == 0 && !final_) ? (row < TP ? P.in[0] + (size_t)row * D : P.in[1] + (size_t)(row - TP) * D) : P.out + (size_t)row * D;
        const float* mp = MOD + (size_t)(l * 34 + stream_of_row(row)) * 6144;
        const float* gp = final_ ? P.in[23] : P.in[7] + l * D;
        f32x4 v[8], g[8], sh[8], sc[8];
#pragma unroll
        for (int j = 0; j < 8; ++j) v[j] = *(const f32x4*)(x + (lane + 64 * j) * 4);
#pragma unroll
        for (int j = 0; j < 8; ++j) g[j] = *(const f32x4*)(gp + (lane + 64 * j) * 4);
        if (!final_) {
#pragma unroll
            for (int j = 0; j < 8; ++j) { sh[j] = *(const f32x4*)(mp + (lane + 64 * j) * 4); sc[j] = *(const f32x4*)(mp + 2048 + (lane + 64 * j) * 4); }
        }
        float ss = 0.f;
#pragma unroll
        for (int j = 0; j < 8; ++j) ss += v[j][0] * v[j][0] + v[j][1] * v[j][1] + v[j][2] * v[j][2] + v[j][3] * v[j][3];
#pragma unroll
        for (int o = 32; o >= 1; o >>= 1) ss += __shfl_xor(ss, o);
        const float rstd = rsqrtf(ss * (1.0f / D) + EPS);
        if (final_) {
#pragma unroll
            for (int j = 0; j < 8; ++j) *(f32x4*)(P.out + (size_t)row * D + (lane + 64 * j) * 4) = v[j] * rstd * g[j];
        } else {
#pragma unroll
            for (int j = 0; j < 8; ++j) { const f32x4 h = v[j] * rstd * g[j] * (1.0f + sc[j]) + sh[j]; u32x2 w; w.x = pk_bf16(h[0], h[1]); w.y = pk_bf16(h[2], h[3]); *(u32x2*)(H + (size_t)row * D + (lane + 64 * j) * 4) = w; }
        }
    }
}
__device__ __forceinline__ void a_unit(const Params& P, LAS unsigned char* lds0, int l, int pm, int h, int par) {
    LAS unsigned char* lds = lds0 + par * 65536;
    const int tid = otid(), wid = __builtin_amdgcn_readfirstlane(tid >> 6), lane = tid & 63, fr = lane & 15, fq = lane >> 4; unsigned char* ws = ows(P.ws);
    bf16_t* XA = (bf16_t*)(ws + WS_BUF + 1 * BUF_BYTES); bf16_t* GA = (bf16_t*)(ws + WS_BUF + 2 * BUF_BYTES);
    const bf16_t* HALO = (const bf16_t*)(ws + WS_HALO);
    const bool is_sample = pm >= 128;
    const int chl = 16 * wid + 4 * fq, chg = h * 128 + chl;
    bf16x8 bfr[2][4];
    { const bf16_t* GT = (const bf16_t*)(ws + WS_GT) + l * GT_L + (size_t)(h * 2) * 16384 + (size_t)(16 * wid + fr) * 128 + 8 * fq;
#pragma unroll
      for (int g = 0; g < 2; ++g)
#pragma unroll
          for (int ks = 0; ks < 4; ++ks) bfr[g][ks] = *(const bf16x8*)(GT + g * 16384 + ks * 32); }
    const f32x4 ba = *(const f32x4*)(P.in[14] + (size_t)l * D + chg), bx = *(const f32x4*)(P.in[16] + (size_t)l * D + chg), lam = *(const f32x4*)(P.in[17] + (size_t)l * D + chg);
    {
        const int chunk = tid & 15, ch0 = h * 128 + chunk * 8, r0 = (tid >> 4) * 8;
        const int tpos0 = is_sample ? (r0 & 63) : ((pm & 63) * 256 + r0);
        F8 xw[11];
#pragma unroll
        for (int j = 0; j < 11; ++j) {
            const int rr = r0 + j - 3, tp = tpos0 + j - 3;
            if (tp < 0) {
                if (is_sample) xw[j] = ldf8(P.in[4] + ((size_t)(l * 32 + (pm - 128) * 4 + (r0 >> 6)) * 3 + (3 + tp)) * D + ch0);
                else {
#pragma unroll
                    for (int i = 0; i < 8; ++i) xw[j].v[i] = 0.f; }
            } else if (rr < 0) xw[j] = unpack8(*(const u32x4*)(HALO + (size_t)((pm - 1) * 3 + 3 + rr) * D + ch0));
            else xw[j] = unpack8(*(const u32x4*)(XA + (size_t)(pm * 256 + rr) * D + ch0));
        }
        const F8 w0 = ldf8(P.in[11] + (size_t)(l * 4 + 0) * D + ch0), w1 = ldf8(P.in[11] + (size_t)(l * 4 + 1) * D + ch0), w2 = ldf8(P.in[11] + (size_t)(l * 4 + 2) * D + ch0), w3 = ldf8(P.in[11] + (size_t)(l * 4 + 3) * D + ch0), cb = ldf8(P.in[12] + (size_t)l * D + ch0);
#pragma unroll
        for (int j = 0; j < 8; ++j) {
            const int row = r0 + j; F8 y;
#pragma unroll
            for (int i = 0; i < 8; ++i) y.v[i] = cb.v[i] + w0.v[i] * xw[j].v[i] + w1.v[i] * xw[j + 1].v[i] + w2.v[i] * xw[j + 2].v[i] + w3.v[i] * xw[j + 3].v[i];
            *(LAS u32x4*)(lds + row * 256 + ((chunk ^ (row >> 4)) & 15) * 16) = pack8(y);
            if (j >= 5) {
                if (is_sample) { if ((r0 & 63) == 56) stf8(P.out + O_CS + ((size_t)(l * 32 + (pm - 128) * 4 + (r0 >> 6)) * 3 + j - 5) * D + ch0, xw[j + 3]); }
                else if ((pm & 63) == 63 && r0 == 248) stf8(P.out + O_CP + ((size_t)(l * 2 + (pm >> 6)) * 3 + j - 5) * D + ch0, xw[j + 3]);
            }
        }
    }
    __syncthreads();
    f32x4 ar[16], ai_[16];
    {
#pragma unroll
        for (int m = 0; m < 16; ++m) { ar[m] = (f32x4){0.f, 0.f, 0.f, 0.f}; ai_[m] = (f32x4){0.f, 0.f, 0.f, 0.f}; }
#pragma unroll
        for (int m = 0; m < 16; ++m) {
#pragma unroll
            for (int ks = 0; ks < 4; ++ks) { const bf16x8 af = *(const LAS bf16x8*)(lds + (16 * fr + m) * 256 + (((4 * ks + fq) ^ fr) & 15) * 16);
                ar[m] = __builtin_amdgcn_mfma_f32_16x16x32_bf16(bfr[0][ks], af, ar[m], 0, 0, 0);
                ai_[m] = __builtin_amdgcn_mfma_f32_16x16x32_bf16(bfr[1][ks], af, ai_[m], 0, 0, 0); } }
    }
    f32x4 nsp2, nspx, bal, bxl;
#pragma unroll
    for (int j = 0; j < 4; ++j) { const float z = -lam[j]; const float nsp = -8.0f * (z > 15.f ? z : log1pf(__expf(z))); nsp2[j] = nsp * 1.44269504f; nspx[j] = 2.0f * nsp; bal[j] = ba[j] * -1.44269504f; bxl[j] = bx[j] * -1.44269504f; }
    f32x4 Ap = (f32x4){1.f, 1.f, 1.f, 1.f}, Bp = (f32x4){0.f, 0.f, 0.f, 0.f};
    const int xoff = ((((chl >> 3) ^ fr) & 15) * 16) + (fq & 1) * 8;
#pragma unroll
    for (int m = 0; m < 16; ++m) {
        const u32x2 xw = *(const LAS u32x2*)(lds + (16 * fr + m) * 256 + xoff);
        const float xc[4] = {bflo(xw.x), bfhi(xw.x), bflo(xw.y), bfhi(xw.y)};
#pragma unroll
        for (int j = 0; j < 4; ++j) {
            const float r = __builtin_amdgcn_rcpf(1.0f + __builtin_amdgcn_exp2f(ar[m][j] * -1.44269504f + bal[j]));
            const float ig = __builtin_amdgcn_rcpf(1.0f + __builtin_amdgcn_exp2f(ai_[m][j] * -1.44269504f + bxl[j]));
            const float a = __builtin_amdgcn_exp2f(nsp2[j] * r), x = nspx[j] * r;
            const float tay = -x * (1.0f + x * (0.5f + x * (0.16666667f + x * (0.041666668f + x * 0.0083333338f))));
            const float em = x > -0.125f ? tay : 1.0f - a * a;
            const float mult = __builtin_amdgcn_sqrtf(fmaxf(em, 0.f));
            const float uu = mult * ig * xc[j];
            Bp[j] = a * Bp[j] + uu; Ap[j] = a * Ap[j];
            ar[m][j] = Ap[j]; ai_[m][j] = Bp[j];
        }
    }
    const int frs = is_sample ? (fr & 3) : fr;
    f32x4 IA = Ap, IB = Bp;
#pragma unroll
    for (int s = 1; s < 16; s <<= 1) {
        f32x4 pa, pb;
#pragma unroll
        for (int j = 0; j < 4; ++j) { pa[j] = __shfl_up(IA[j], s, 16); pb[j] = __shfl_up(IB[j], s, 16); }
        if (frs >= s) {
#pragma unroll
            for (int j = 0; j < 4; ++j) { IB[j] = IA[j] * pb[j] + IB[j]; IA[j] = IA[j] * pa[j]; } }
    }
    f32x4 EA, EB;
#pragma unroll
    for (int j = 0; j < 4; ++j) { EA[j] = __shfl_up(IA[j], 1, 16); EB[j] = __shfl_up(IB[j], 1, 16); }
    if (frs == 0) { EA = (f32x4){1.f, 1.f, 1.f, 1.f}; EB = (f32x4){0.f, 0.f, 0.f, 0.f}; }
    {
        float* AGG = (float*)(ws + WS_AGG);
        const bool lastl = is_sample ? ((fr & 3) == 3) : (fr == 15);
        if (lastl) { const int chunk = is_sample ? 128 + (pm - 128) * 4 + (fr >> 2) : pm; float* ap = AGG + ((size_t)chunk * D + chg) * 2;
            *(f32x4*)ap = (f32x4){IA[0], IB[0], IA[1], IB[1]}; *(f32x4*)(ap + 4) = (f32x4){IA[2], IB[2], IA[3], IB[3]}; }
    }
    u32x2 sgw[16];
    int frz = fr; asm volatile("" : "+v"(frz) : "v"(EA[0]));
#pragma unroll
    for (int m = 0; m < 16; ++m) sgw[m] = *(const u32x2*)(GA + (size_t)(pm * 256 + 16 * frz + m) * D + chg);
#pragma unroll
    for (int m = 0; m < 16; ++m) {
        const size_t off = (size_t)(pm * 256 + 16 * fr + m) * D + chg;
        const u32x2 sw = sgw[m];
        const float sg[4] = {bflo(sw.x), bfhi(sw.x), bflo(sw.y), bfhi(sw.y)};
        float pv[4], qv[4];
#pragma unroll
        for (int j = 0; j < 4; ++j) { const float acum = EA[j] * ar[m][j], hloc = ar[m][j] * EB[j] + ai_[m][j]; pv[j] = hloc * sg[j]; qv[j] = acum * sg[j]; }
        u32x2 pw, qw; pw.x = pk_bf16(pv[0], pv[1]); pw.y = pk_bf16(pv[2], pv[3]); qw.x = pk_bf16(qv[0], qv[1]); qw.y = pk_bf16(qv[2], qv[3]);
        *(u32x2*)(XA + off) = pw; *(u32x2*)(GA + off) = qw;
    }
}
template <int W, int R>
__device__ __forceinline__ void pool_block(const Params& P, const bf16_t* XB, bf16_t* DB, int l, int token0, int g, int lane) {
    const int ch0 = g * 512 + lane * 8;
    const bool smp = token0 >= TP;
    const int sidx = smp ? (token0 - TP) >> 6 : token0 >> 14, tpos0 = smp ? (token0 - TP) & 63 : token0 & 16383;
    u32x4 raw[R + W - 1];
#pragma unroll
    for (int i = 0; i < R + W - 1; ++i) {
        const int r = i - (W - 1), tp = tpos0 + r;
        if (tp >= 0) raw[i] = *(const u32x4*)(XB + (size_t)(token0 + r) * D + ch0);
        else if (smp) raw[i] = pack8(ldf8(P.in[6] + ((size_t)(l * 32 + sidx) * 15 + (15 + tp)) * D + ch0));
        else raw[i] = (u32x4){0u, 0u, 0u, 0u};
    }
    F8 sum;
#pragma unroll
    for (int i = 0; i < 8; ++i) sum.v[i] = 0.f;
#pragma unroll
    for (int i = 0; i < W - 1; ++i) { const F8 x = unpack8(raw[i]);
#pragma unroll
        for (int k = 0; k < 8; ++k) sum.v[k] += x.v[k]; }
#pragma unroll
    for (int r = 0; r < R; ++r) {
        const F8 x = unpack8(raw[r + W - 1]), xo = unpack8(raw[r]);
        const int tp = tpos0 + r; const float ic = 1.0f / (smp ? (float)W : (float)(W < tp + 1 ? W : tp + 1));
        F8 d;
#pragma unroll
        for (int k = 0; k < 8; ++k) { sum.v[k] += x.v[k]; d.v[k] = sum.v[k] * ic - x.v[k]; sum.v[k] -= xo.v[k]; }
        *(u32x4*)(DB + (size_t)(token0 + r) * D + ch0) = pack8(d);
        if (smp) { if (tp >= 49) stf8(P.out + O_PS + ((size_t)(l * 32 + sidx) * 15 + tp - 49) * D + ch0, x); }
        else if (tp >= 16369) stf8(P.out + O_PP + ((size_t)(l * 2 + sidx) * 15 + tp - 16369) * D + ch0, x);
    }
}
__device__ void pool_pass(const Params& P, int l) {
    const int tid = otid(), wid = __builtin_amdgcn_readfirstlane(tid >> 6), lane = tid & 63; unsigned char* ws = ows(P.ws);
    const bf16_t* XB = (const bf16_t*)(ws + WS_BUF + 3 * BUF_BYTES); bf16_t* DB = (bf16_t*)(ws + WS_BUF + 5 * BUF_BYTES);
    const int G = gridDim.x, nbig = (NT * 16) % G, nsmall = nbig ? G - nbig : 0, nx = nsmall * 8 * 2, total = (T / 16) * 4;
    for (int pass = 0; pass < 2; ++pass)
    for (int item = pass == 0 ? ((int)blockIdx.x >= nbig && nsmall ? ((int)blockIdx.x - nbig) * 8 + wid : total) : nx + (int)blockIdx.x * 8 + wid; item < (pass == 0 ? nx : total); item += (pass == 0 ? nsmall : G) * 8) {
        const int rb = item >> 2, g = item & 3;
        if (g == 0) pool_block<2, 16>(P, XB, DB, l, rb * 16, g, lane);
        else if (g == 1) pool_block<4, 16>(P, XB, DB, l, rb * 16, g, lane);
        else if (g == 2) pool_block<8, 16>(P, XB, DB, l, rb * 16, g, lane);
        else {
#pragma nounroll
            for (int hb = 0; hb < 2; ++hb) pool_block<16, 8>(P, XB, DB, l, rb * 16 + hb * 8, g, lane); }
    }
}
__device__ void fixup_phase(const Params& P, LAS unsigned char* lds, int l, int first, int stride, int end) {
    const int tid = otid(), cgq = tid & 31, rr = tid >> 5; unsigned char* ws = ows(P.ws);
    bf16_t* PB = (bf16_t*)(ws + WS_BUF + 1 * BUF_BYTES); const bf16_t* QB = (const bf16_t*)(ws + WS_BUF + 2 * BUF_BYTES);
    const f32x2* AGG = (const f32x2*)(ws + WS_AGG);
    LAS float* cs = (LAS float*)lds;
    for (int item = first; item < end; item += stride) {
        const int pm = item >> 3, cb = item & 7;
        const bool smp = pm >= 128;
        __syncthreads();
        if (tid < 256) {
            const int ch = cb * 256 + tid;
            if (!smp) { const int st = pm >> 6, tl = pm & 63; float c = 0.f; const f32x2* ap = AGG + (size_t)(st * 64) * D + ch;
                int j = 0;
                for (; j + 8 <= tl; j += 8) { f32x2 q[8];
#pragma unroll
                    for (int k = 0; k < 8; ++k) q[k] = ap[(size_t)(j + k) * D];
#pragma unroll
                    for (int k = 0; k < 8; ++k) c = q[k][0] * c + q[k][1]; }
                for (; j < tl; ++j) { const f32x2 q = ap[(size_t)j * D]; c = q[0] * c + q[1]; }
                cs[tid] = c; cs[256 + tid] = c; cs[512 + tid] = c; cs[768 + tid] = c;
                if (tl == 63) { const f32x2 q = ap[(size_t)63 * D]; P.out[O_LP + (size_t)(l * 2 + st) * D + ch] = q[0] * c + q[1]; }
            } else {
#pragma unroll
                for (int q4 = 0; q4 < 4; ++q4) { const int s = (pm - 128) * 4 + q4; const float h0 = P.in[5][(size_t)(l * 32 + s) * D + ch]; const f32x2 q = AGG[(size_t)(128 + s) * D + ch];
                    cs[q4 * 256 + tid] = h0; P.out[O_LS + (size_t)(l * 32 + s) * D + ch] = q[0] * h0 + q[1]; }
            }
        }
        __syncthreads();
        const int ch0 = cb * 256 + cgq * 8;
#pragma unroll
        for (int half = 0; half < 2; ++half) {
            u32x4 pv[8], qv[8];
#pragma unroll
            for (int k = 0; k < 8; ++k) { const size_t off = (size_t)(pm * 256 + (half * 8 + k) * 16 + rr) * D + ch0; pv[k] = *(const u32x4*)(PB + off); qv[k] = *(const u32x4*)(QB + off); }
#pragma unroll
            for (int k = 0; k < 8; ++k) { const int seg = (half * 8 + k) >> 2; const size_t off = (size_t)(pm * 256 + (half * 8 + k) * 16 + rr) * D + ch0;
                const f32x4 c0 = *(const LAS f32x4*)(cs + seg * 256 + cgq * 8), c1 = *(const LAS f32x4*)(cs + seg * 256 + cgq * 8 + 4);
                const F8 p = unpack8(pv[k]), q = unpack8(qv[k]); F8 y;
#pragma unroll
                for (int i = 0; i < 4; ++i) { y.v[i] = p.v[i] + q.v[i] * c0[i]; y.v[4 + i] = p.v[4 + i] + q.v[4 + i] * c1[i]; }
                *(u32x4*)(PB + off) = pack8(y); }
        }
    }
    __syncthreads();
}


#define XB_TMO      128
#define XB_XCNT(j)  (256  + 64 * (j))
#define XB_XSUB(j)  (1280 + 64 * (j))
#define XB_XGEN(j)  (2304 + 64 * (j))
#define XB_TOP      3328
#define XB_TOPGEN   3392
#define XCD_BAR_WORDS 3456
#define XB_SPIN_CAP (1u << 22)
constexpr size_t WS_BAR = (size_t)7 << 20;
__device__ __forceinline__ unsigned xb_ld(unsigned* p)              { return __hip_atomic_load(p, __ATOMIC_RELAXED, __HIP_MEMORY_SCOPE_AGENT); }
__device__ __forceinline__ unsigned xb_add(unsigned* p, unsigned v) { return __hip_atomic_fetch_add(p, v, __ATOMIC_RELAXED, __HIP_MEMORY_SCOPE_AGENT); }
__device__ __forceinline__ unsigned xb_xcc_id() { return (unsigned)__builtin_amdgcn_s_getreg((3 << 11) | 20) & 0xFu; }
#define XB_SPIN(cond, bar) do { unsigned _sp = 0; while (cond) { __builtin_amdgcn_s_sleep(1); \
    if ((++_sp & 255u) == 0u) { if (xb_ld(&(bar)[XB_TMO])) break; if (_sp > XB_SPIN_CAP) { atomicAdd(&(bar)[XB_TMO], 1u); break; } } } } while (0)
struct XcdBarrier { unsigned* bar; unsigned x; volatile LAS unsigned* st; };
__device__ __forceinline__ XcdBarrier xcd_barrier_post(unsigned* bar, volatile LAS unsigned* st) {
    XcdBarrier b; b.bar = bar; b.x = xb_xcc_id(); b.st = st;
    if (threadIdx.x == 0) (void)xb_add(&bar[XB_XCNT(b.x)], 1u);
    return b;
}
__device__ __forceinline__ void xcd_barrier_complete(unsigned* bar, unsigned x, unsigned& nloc, unsigned& nx) {
    const unsigned G = gridDim.x * gridDim.y * gridDim.z;
    unsigned sum, cnt, mine, sp = 0u;
    for (;;) {
        sum = 0u; cnt = 0u; mine = 0u;
#pragma unroll
        for (unsigned j = 0; j < 16; ++j) { const unsigned c = xb_ld(&bar[XB_XCNT(j)]); sum += c; cnt += (c > 0u) ? 1u : 0u; mine = (j == x) ? c : mine; }
        if (sum == G) break;
        __builtin_amdgcn_s_sleep(1);
        if ((++sp & 255u) == 0u) { if (xb_ld(&bar[XB_TMO])) break; if (sp > XB_SPIN_CAP) { atomicAdd(&bar[XB_TMO], 1u); break; } }
    }
    nloc = mine > 0u ? mine : 1u; nx = cnt > 0u ? cnt : 1u;
}
__device__ __forceinline__ void xcd_barrier(const XcdBarrier& b) {
    asm volatile("s_waitcnt vmcnt(0)" ::: "memory");
    __syncthreads();
    if (threadIdx.x == 0) {
        unsigned* bar = b.bar;
        __builtin_amdgcn_s_waitcnt(0);
        unsigned nloc = b.st[0], nx = b.st[1];
        if (nloc == 0u) { xcd_barrier_complete(bar, b.x, nloc, nx); b.st[0] = nloc; b.st[1] = nx; }
        const unsigned old = xb_add(&bar[XB_XSUB(b.x)], 1u);
        const unsigned gen = old / nloc;
        if (old + 1u == (gen + 1u) * nloc) {
            __builtin_amdgcn_fence(__ATOMIC_RELEASE, "agent");
            asm volatile("s_waitcnt vmcnt(0)" ::: "memory");
            const unsigned og = xb_add(&bar[XB_TOP], 1u);
            const unsigned tg = og / nx;
            if (og + 1u == (tg + 1u) * nx) xb_add(&bar[XB_TOPGEN], 1u);
            else XB_SPIN(xb_ld(&bar[XB_TOPGEN]) == tg, bar);
            __builtin_amdgcn_fence(__ATOMIC_ACQUIRE, "agent");
            xb_add(&bar[XB_XGEN(b.x)], 1u);
            asm volatile("s_waitcnt vmcnt(0)" ::: "memory");
        } else {
            XB_SPIN(xb_ld(&bar[XB_XGEN(b.x)]) == gen, bar);
            __builtin_amdgcn_fence(__ATOMIC_ACQUIRE, "agent");
            asm volatile("s_waitcnt vmcnt(0)" ::: "memory");
        }
    }
    __syncthreads();
}

__global__ void __launch_bounds__(512, 2) fwd_kernel(Params P) {
    extern __shared__ __attribute__((aligned(16))) unsigned char shm[];
    LAS unsigned char* lds = (LAS unsigned char*)shm;
    cg::grid_group grid = cg::this_grid();
    const int lo = P.ph_lo, hi = P.ph_hi;
    const int G = gridDim.x, bx = blockIdx.x;
    volatile LAS unsigned* bst = (volatile LAS unsigned*)(lds + LDS_BYTES - 16);
    if (threadIdx.x < 4) bst[threadIdx.x] = 0u;
    __syncthreads();
    XcdBarrier xbar; xbar.bar = (unsigned*)(P.ws + WS_BAR); xbar.x = 0; xbar.st = bst;
    if (P.coop) xbar = xcd_barrier_post((unsigned*)(P.ws + WS_BAR), bst);
    if (P.pad == 0x7fffffff) grid.sync();
#define PHASE_PTRS unsigned char* ws = ows(P.ws); bf16_t* H = (bf16_t*)(ws + WS_BUF); bf16_t* B0 = H + BUF_ELEMS; bf16_t* B1 = B0 + BUF_ELEMS; bf16_t* B2 = B1 + BUF_ELEMS; bf16_t* B3 = B2 + BUF_ELEMS; bf16_t* B4 = B3 + BUF_ELEMS; \
    (void)H; (void)B0; (void)B1; (void)B2; (void)B3; (void)B4
#pragma nounroll
    for (int ph = lo; ph < hi; ++ph) {
        if (ph == 0) { mod_phase(P, lds); transpose_phase(P, lds); }
        else if (ph == 15) norm_phase(P, 0, true);
        else {
            const int l = (ph - 1) / 7, s = (ph - 1) % 7;
            if (s == 0) norm_phase(P, l, false);
            else if (s == 1 || s == 4) {
                PHASE_PTRS; const bf16_t* WinT = (const bf16_t*)(ws + WS_WIN) + l * WIN_L;
                const bool first = s == 1;
                pg8::Gemm g{H, first ? WinT : WinT + (size_t)8192 * D, nullptr}; pg8::StaticOrder S; S.init(T, first ? 8192 : 4096, G, bx);
                EpiAct E{first ? B0 : B2, first ? (long)BUF_ELEMS : 2 * (long)BUF_ELEMS, first ? 0 : 2, first ? 1 : 2, first ? (bf16_t*)(ws + WS_HALO) : (bf16_t*)nullptr};
                pg8::gemm_phase<EpiAct, D, D, D, 0, 0>(lds, g, S, E);
                if (!first) {
                    const int nidle = G - (2176 % G);
                    if (2176 % G != 0 && bx >= G - nidle) fixup_phase(P, lds, l, (NT * 8) / 2 + (bx - (G - nidle)), nidle, NT * 8);
                    else if (2176 % G == 0) fixup_phase(P, lds, l, (NT * 8) / 2 + bx, G, NT * 8);
                }
            } else if (s == 2) {
                { int par = 0; for (int item = bx; item < NT * 16; item += G, par ^= 1) a_unit(P, lds, l, item >> 4, item & 15, par); }
                __syncthreads();
                pool_pass(P, l);
            } else if (s == 3) {
                { PHASE_PTRS; const bf16_t* PoolT = (const bf16_t*)(ws + WS_POOL) + l * POOL_L;
                  pg8::Gemm g{B4, PoolT, nullptr}; pg8::StaticOrder S; S.init(T, D, G, bx);
                  EpiPool E{B3, P.in[19] + (size_t)l * D};
                  pg8::gemm_phase<EpiPool, 512, D, 512, 1, 512>(lds, g, S, E); }
                fixup_phase(P, lds, l, bx, G, (NT * 8) / 2);
            } else if (s == 5) {
                PHASE_PTRS; const bf16_t* WcatT = (const bf16_t*)(ws + WS_WCAT) + l * WCAT_L;
                pg8::Gemm g{B0, WcatT, B3}; pg8::StaticOrder S; S.init(T, D, G, bx); EpiGate2 E{B2, B4, H};
                pg8::gemm_phase<EpiGate2, 4096, D, 4096, 0, 0, 2>(lds, g, S, E);
            } else {
                PHASE_PTRS; const bf16_t* WoT = (const bf16_t*)(ws + WS_WO) + l * WO_L; const float* MODl = (const float*)(ws + WS_MOD) + (size_t)l * 34 * 6144;
                pg8::Gemm g{H, WoT, nullptr}; pg8::StaticOrder S; S.init(T, D, G, bx);
                EpiRes E{l == 0 ? P.in[0] : P.out, l == 0 ? P.in[1] : P.out + (size_t)TP * D, P.out, MODl};
                pg8::gemm_phase<EpiRes, D, D, D, 0, 0>(lds, g, S, E);
            }
        }
        if (P.coop && ph + 1 < hi) xcd_barrier(xbar);
    }

}

extern "C" void kernel_launch(void* const* d_in, const int* in_sizes, int n_in, void* d_out, int out_size, void* d_ws, size_t ws_size, hipStream_t stream) {
    static int grid = 0;
    if (grid == 0) {
        int dev = 0, cus = 0, per_cu = 0;
        hipGetDevice(&dev);
        hipDeviceGetAttribute(&cus, hipDeviceAttributeMultiprocessorCount, dev);
        if (hipFuncSetAttribute((const void*)fwd_kernel, hipFuncAttributeMaxDynamicSharedMemorySize, LDS_BYTES) != hipSuccess) fprintf(stderr, "kernel_launch: hipFuncSetAttribute failed\n");
        if (hipOccupancyMaxActiveBlocksPerMultiprocessor(&per_cu, (const void*)fwd_kernel, 512, LDS_BYTES) != hipSuccess || per_cu < 1) { fprintf(stderr, "kernel_launch: occupancy query says %d\n", per_cu); per_cu = 1; }
        (void)hipGetLastError();
        grid = cus * 1;
        if (n_in != 24 || ws_size < WS_BUF + 6 * BUF_BYTES) fprintf(stderr, "kernel_launch: unexpected n_in %d / ws_size %zu\n", n_in, ws_size);
    }
    Params p{};
    for (int i = 0; i < 24; ++i) p.in[i] = (const float*)d_in[i];
    p.out = (float*)d_out; p.ws = (unsigned char*)d_ws;
#if N_LAUNCH_MODE == 1
    p.ph_lo = 0; p.ph_hi = NPH; p.coop = 1; p.pad = 0;
    if (hipMemsetAsync((char*)d_ws + WS_BAR, 0, XCD_BAR_WORDS * 4, stream) != hipSuccess) fprintf(stderr, "kernel_launch: memset of barrier words failed\n");
    void* args[] = {&p};
    hipError_t e = hipLaunchCooperativeKernel((const void*)fwd_kernel, dim3(grid), dim3(512), args, LDS_BYTES, stream);
    if (e != hipSuccess) fprintf(stderr, "cooperative launch failed: %s (grid %d)\n", hipGetErrorString(e), grid);
#else
    for (int k = 0; k < NPH; ++k) { p.ph_lo = k; p.ph_hi = k + 1; p.coop = 0; p.pad = 0; hipLaunchKernelGGL(fwd_kernel, dim3(grid), dim3(512), LDS_BYTES, stream, p); }
#endif
}
```
